# Optimizing an MI355X kernel written in HIP

```python
import math
import jax
import jax.numpy as jnp
from jax import lax
import numpy as np

D_MODEL = 1024
BATCH = 2
SEQ = 16384
DEPTH = 4
DEC_BATCH = 1
DEC_SEQ = 16384
PAST_LEN = 128

N_MIXERS = 3
EXPAND = 2
D_INNER = EXPAND * D_MODEL
EPS = 1e-6

SG_CHUNK = 128
SG_GROUPS = 8
SG_GDIM = D_INNER // SG_GROUPS

GLA_HEADS = 4
GLA_KEY = D_MODEL // 2
GLA_DK = GLA_KEY // GLA_HEADS
GLA_DV = D_INNER // GLA_HEADS
GLA_RANK = 16
GLA_TAU = 16.0
GLA_CHUNK = 64
GLA_IN = 2 * GLA_KEY + 2 * D_INNER + 2 * GLA_RANK
GLA_SPLITS = (GLA_KEY, 2 * GLA_KEY, 2 * GLA_KEY + D_INNER, 2 * GLA_KEY + 2 * D_INNER,
              2 * GLA_KEY + 2 * D_INNER + GLA_RANK)

DIFF_HEADS = 8
DIFF_DQK = 128
DIFF_DV = D_INNER // DIFF_HEADS
DIFF_QBLOCK = 128
DIFF_IN = 4 * D_INNER

N_LAYERS_A = (DEPTH + 2) // N_MIXERS
N_LAYERS_B = (DEPTH + 1) // N_MIXERS
N_LAYERS_C = DEPTH // N_MIXERS

kernel_name = 'hybrid_bidir_sgu_gla_diffattn_encoder'


def rms_norm(x, g):
    xf = x.astype(jnp.float32)
    y = xf * lax.rsqrt(jnp.mean(xf * xf, axis=-1, keepdims=True) + EPS)
    return (y * g.astype(jnp.float32)).astype(x.dtype)


def spatial_gating_mixer(h, w_in, v_g, w_s, b_s, w_out):
    b, s, _ = h.shape
    n = s // SG_CHUNK
    u, v, z = jnp.split(h @ w_in, 3, axis=-1)
    v = rms_norm(v, v_g).reshape(b, n, SG_CHUNK, SG_GROUPS, SG_GDIM)
    sv = jnp.einsum('gqp,bnpgc->bnqgc', w_s, v) + jnp.swapaxes(b_s, 0, 1)[:, :, None]
    y = u * sv.reshape(b, s, D_INNER)
    return (y * jax.nn.silu(z)) @ w_out


def gla_direction(q, k, v, log_a, strict):
    b, s, nh, dk = q.shape
    dv = v.shape[-1]
    c = GLA_CHUNK
    n = s // c
    qc, kc, vc, lc = (t.astype(jnp.float32).reshape(b, n, c, nh, t.shape[-1]) for t in (q, k, v, log_a))
    cum = jnp.cumsum(lc, axis=2)
    ref = cum[:, :, c // 2:c // 2 + 1]
    scores = jnp.einsum('bnthd,bnshd->bnhts', qc * jnp.exp(cum - ref), kc * jnp.exp(ref - cum))
    idx = jnp.arange(c)
    mask = (idx[:, None] > idx[None, :]) if strict else (idx[:, None] >= idx[None, :])
    scores = jnp.where(mask, scores, 0.0)
    o_intra = jnp.einsum('bnhts,bnshv->bnthv', scores, vc)
    last = cum[:, :, -1:]
    q_inter = qc * jnp.exp(cum)
    k_inter = kc * jnp.exp(last - cum)
    decay = jnp.exp(last[:, :, 0])

    def step(state, xs):
        qi, ki, vi, di = xs
        o = jnp.einsum('bthd,bhdv->bthv', qi, state)
        state = state * di[..., None] + jnp.einsum('bthd,bthv->bhdv', ki, vi)
        return state, o

    state0 = jnp.zeros((b, nh, dk, dv), jnp.float32)
    xs = tuple(jnp.moveaxis(t, 1, 0) for t in (q_inter, k_inter, vc, decay))
    _, o_inter = lax.scan(step, state0, xs)
    o = o_intra + jnp.moveaxis(o_inter, 0, 1)
    return o.reshape(b, s, nh, dv)


def gla_mixer(h, w_in, w_gate, gate_bias, o_g, w_out):
    b, s, _ = h.shape
    q, k, v, g, a_f, a_b = jnp.split(h @ w_in, GLA_SPLITS, axis=-1)
    q = q.reshape(b, s, GLA_HEADS, GLA_DK) * GLA_DK ** -0.5
    k = k.reshape(b, s, GLA_HEADS, GLA_DK)
    v = v.reshape(b, s, GLA_HEADS, GLA_DV)

    def log_decay(code, w, bias):
        pre = (code @ w + bias).astype(jnp.float32)
        return (jax.nn.log_sigmoid(pre) / GLA_TAU).reshape(b, s, GLA_HEADS, GLA_DK)

    la_f = log_decay(a_f, w_gate[0], gate_bias[0])
    la_b = log_decay(a_b, w_gate[1], gate_bias[1])
    flip = lambda t: jnp.flip(t, axis=1)
    o_f = gla_direction(q, k, v, la_f, strict=False)
    o_b = flip(gla_direction(flip(q), flip(k), flip(v), flip(la_b), strict=True))
    o = rms_norm(o_f + o_b, o_g).astype(h.dtype).reshape(b, s, D_INNER)
    return (o * jax.nn.silu(g)) @ w_out


def diff_attn_mixer(h, w_in, q_g, k_g, lam, o_g, w_out, lambda_init):
    b, s, _ = h.shape
    nb = s // DIFF_QBLOCK
    q, k, v, z = jnp.split(h @ w_in, 4, axis=-1)
    q = rms_norm(q.reshape(b, s, DIFF_HEADS, 2, DIFF_DQK), q_g)
    k = rms_norm(k.reshape(b, s, DIFF_HEADS, 2, DIFF_DQK), k_g)
    kf = k.astype(jnp.float32)
    vf = v.reshape(b, s, DIFF_HEADS, DIFF_DV).astype(jnp.float32)
    lf = lam.astype(jnp.float32)
    lam_full = jnp.exp(jnp.sum(lf[0] * lf[1])) - jnp.exp(jnp.sum(lf[2] * lf[3])) + lambda_init
    slopes = jnp.asarray(2.0 ** (-8.0 * np.arange(1, DIFF_HEADS + 1) / DIFF_HEADS), jnp.float32)
    pos_k = jnp.arange(s, dtype=jnp.float32)
    qb = (q.astype(jnp.float32) * DIFF_DQK ** -0.5).reshape(b, nb, DIFF_QBLOCK, DIFF_HEADS, 2, DIFF_DQK)
    qb = jnp.moveaxis(qb, 1, 0)
    starts = jnp.arange(nb, dtype=jnp.float32) * DIFF_QBLOCK

    def block(args):
        qi, start = args
        logits = jnp.einsum('bqhmd,bkhmd->bhmqk', qi, kf)
        pos_q = start + jnp.arange(DIFF_QBLOCK, dtype=jnp.float32)
        dist = jnp.abs(pos_q[:, None] - pos_k[None, :])
        logits = logits - slopes[None, :, None, None, None] * dist[None, None, None]
        p = jax.nn.softmax(logits, axis=-1)
        attn = p[:, :, 0] - lam_full * p[:, :, 1]
        return jnp.einsum('bhqk,bkhv->bqhv', attn, vf)

    o = lax.map(block, (qb, starts))
    o = jnp.moveaxis(o, 0, 1).reshape(b, s, DIFF_HEADS, DIFF_DV)
    o = (rms_norm(o, o_g) * (1.0 - lambda_init)).astype(h.dtype).reshape(b, s, D_INNER)
    return (o * jax.nn.silu(z)) @ w_out


def trunk(x, norm_g, a_w_in, a_v_g, a_w_s, a_b_s, a_w_out,
          b_w_in, b_w_gate, b_gate_bias, b_o_g, b_w_out,
          c_w_in, c_q_g, c_k_g, c_lam, c_o_g, c_w_out):
    for i in range(DEPTH):
        h = rms_norm(x, norm_g[i])
        kind, j = i % N_MIXERS, i // N_MIXERS
        if kind == 0:
            y = spatial_gating_mixer(h, a_w_in[j], a_v_g[j], a_w_s[j], a_b_s[j], a_w_out[j])
        elif kind == 1:
            y = gla_mixer(h, b_w_in[j], b_w_gate[j], b_gate_bias[j], b_o_g[j], b_w_out[j])
        else:
            lambda_init = 0.8 - 0.6 * math.exp(-0.3 * i)
            y = diff_attn_mixer(h, c_w_in[j], c_q_g[j], c_k_g[j], c_lam[j], c_o_g[j], c_w_out[j], lambda_init)
        x = x + y.astype(x.dtype)
    return x


def setup_inputs(seed: int = 0) -> dict:
    key = jax.random.key(seed)
    ks = jax.random.split(key, 20)
    f32 = jnp.float32

    def nrm(k, shape, scale):
        return jax.random.normal(k, shape, f32) * scale

    return {
        'x_prompt': nrm(ks[0], (BATCH, SEQ, D_MODEL), 1.0),
        'x_sample': nrm(ks[1], (DEC_BATCH, DEC_SEQ, D_MODEL), 1.0),
        'norm_g': 1.0 + nrm(ks[2], (DEPTH, D_MODEL), 0.02),
        'a_w_in': nrm(ks[3], (N_LAYERS_A, D_MODEL, 3 * D_INNER), D_MODEL ** -0.5),
        'a_v_g': 1.0 + nrm(ks[4], (N_LAYERS_A, D_INNER), 0.02),
        'a_w_s': nrm(ks[5], (N_LAYERS_A, SG_GROUPS, SG_CHUNK, SG_CHUNK), SG_CHUNK ** -0.5),
        'a_b_s': 1.0 + nrm(ks[6], (N_LAYERS_A, SG_GROUPS, SG_CHUNK), 0.1),
        'a_w_out': nrm(ks[7], (N_LAYERS_A, D_INNER, D_MODEL), D_INNER ** -0.5),
        'b_w_in': nrm(ks[8], (N_LAYERS_B, D_MODEL, GLA_IN), D_MODEL ** -0.5),
        'b_w_gate': nrm(ks[9], (N_LAYERS_B, 2, GLA_RANK, GLA_KEY), GLA_RANK ** -0.5),
        'b_gate_bias': nrm(ks[10], (N_LAYERS_B, 2, GLA_KEY), 0.1),
        'b_o_g': 1.0 + nrm(ks[11], (N_LAYERS_B, GLA_DV), 0.02),
        'b_w_out': nrm(ks[12], (N_LAYERS_B, D_INNER, D_MODEL), D_INNER ** -0.5),
        'c_w_in': nrm(ks[13], (N_LAYERS_C, D_MODEL, DIFF_IN), D_MODEL ** -0.5),
        'c_q_g': 1.0 + nrm(ks[14], (N_LAYERS_C, DIFF_DQK), 0.02),
        'c_k_g': 1.0 + nrm(ks[15], (N_LAYERS_C, DIFF_DQK), 0.02),
        'c_lam': nrm(ks[16], (N_LAYERS_C, 4, DIFF_DQK), 0.1),
        'c_o_g': 1.0 + nrm(ks[17], (N_LAYERS_C, DIFF_DV), 0.02),
        'c_w_out': nrm(ks[18], (N_LAYERS_C, D_INNER, D_MODEL), D_INNER ** -0.5),
    }


def reference(x_prompt, x_sample, norm_g, a_w_in, a_v_g, a_w_s, a_b_s, a_w_out,
              b_w_in, b_w_gate, b_gate_bias, b_o_g, b_w_out,
              c_w_in, c_q_g, c_k_g, c_lam, c_o_g, c_w_out):
    y_prompt = trunk(x_prompt, norm_g, a_w_in, a_v_g, a_w_s, a_b_s, a_w_out,
                     b_w_in, b_w_gate, b_gate_bias, b_o_g, b_w_out,
                     c_w_in, c_q_g, c_k_g, c_lam, c_o_g, c_w_out)
    y_sample = trunk(x_sample, norm_g, a_w_in, a_v_g, a_w_s, a_b_s, a_w_out,
                     b_w_in, b_w_gate, b_gate_bias, b_o_g, b_w_out,
                     c_w_in, c_q_g, c_k_g, c_lam, c_o_g, c_w_out)
    return (y_prompt, y_sample)
```

```cpp
#include <hip/hip_runtime.h>
#include <hip/hip_cooperative_groups.h>
#include <cstdio>
namespace cg = cooperative_groups;

#define DI __device__ __forceinline__
#define LAS __attribute__((address_space(3)))
typedef unsigned short bf16_t;
typedef short bf16x8 __attribute__((ext_vector_type(8)));
typedef short s16x4 __attribute__((ext_vector_type(4)));
typedef float f32x2 __attribute__((ext_vector_type(2)));
typedef float f32x4 __attribute__((ext_vector_type(4)));
typedef float f32x16 __attribute__((ext_vector_type(16)));
typedef unsigned u32x4 __attribute__((ext_vector_type(4)));
typedef unsigned u32x2 __attribute__((ext_vector_type(2)));
typedef __bf16 bf16x2_t __attribute__((ext_vector_type(2)));

constexpr int SEQ = 16384, DM = 1024, DIN = 2048, NSEQ = 3, NTOK = NSEQ * SEQ;
constexpr float EPS = 1e-6f;
constexpr size_t MiB = 1u << 20;
constexpr size_t WS_W = 0, WS_WOUT = 16 * MiB, WS_XB = 20 * MiB, WS_ACT = 116 * MiB, WS_Y = 412 * MiB, WS_MISC = 476 * MiB;
constexpr size_t WS_GLAE = WS_MISC, WS_VSS = WS_MISC + 4 * MiB, WS_CTR = WS_VSS + 2 * MiB, WS_RSTD = WS_CTR + 1 * MiB, WS_XSSP = WS_RSTD + 1 * MiB, WS_BAR = WS_XSSP + 3 * MiB, WS_END = WS_BAR + 65536;
constexpr int LDS_BYTES = 144 * 1024;
constexpr int NA = 6144, NB = 5376, NC = 8192;

struct Params {
  const float* x_prompt; const float* x_sample; const float* norm_g;
  const float* a_w_in; const float* a_v_g; const float* a_w_s; const float* a_b_s; const float* a_w_out;
  const float* b_w_in; const float* b_w_gate; const float* b_gate_bias; const float* b_o_g; const float* b_w_out;
  const float* c_w_in; const float* c_q_g; const float* c_k_g; const float* c_lam; const float* c_o_g; const float* c_w_out;
  float* out; unsigned char* ws;
};

DI unsigned cvt2(float a, float b) { f32x2 v = {a, b}; bf16x2_t r = __builtin_convertvector(v, bf16x2_t); return __builtin_bit_cast(unsigned, r); }
DI float bf2f(bf16_t v) { return __uint_as_float(((unsigned)v) << 16); }
DI float bflo(unsigned w) { return __uint_as_float(w << 16); }
DI float bfhi(unsigned w) { return __uint_as_float(w & 0xffff0000u); }
DI bf16_t f2bf(float a) { return (bf16_t)(cvt2(a, 0.f) & 0xffffu); }
DI int opq(int x) { asm volatile("" : "+v"(x)); return x; }
DI int tid_of(int wv) { int l; asm volatile("v_mbcnt_lo_u32_b32 %0, -1, 0\n\tv_mbcnt_hi_u32_b32 %0, -1, %0" : "=v"(l)); return (wv << 6) | l; }
DI int crow(int r, int hi) { return (r & 3) + 8 * (r >> 2) + 4 * hi; }
DI float wave_sum(float v) { for (int o = 32; o >= 1; o >>= 1) v += __shfl_xor(v, o); return v; }
DI float silu(float z) { return z * __builtin_amdgcn_rcpf(1.f + __expf(-z)); }
#define MFMA32(a, b, c) __builtin_amdgcn_mfma_f32_32x32x16_bf16((a), (b), (c), 0, 0, 0)
template <int OFF> DI s16x4 tr_read(unsigned addr) { s16x4 r; asm volatile("ds_read_b64_tr_b16 %0, %1 offset:%2" : "=&v"(r) : "v"(addr), "i"(OFF) : "memory"); return r; }
DI s16x4 tr_read0(unsigned addr) { s16x4 r; asm volatile("ds_read_b64_tr_b16 %0, %1" : "=&v"(r) : "v"(addr) : "memory"); return r; }
#define LGKM0() asm volatile("s_waitcnt lgkmcnt(0)" ::: "memory")
#define SBAR() __builtin_amdgcn_sched_barrier(0)
#define PK8(L, H) (bf16x8){L[0], L[1], L[2], L[3], H[0], H[1], H[2], H[3]}
DI bf16x8 pack8(float a0, float a1, float a2, float a3, float a4, float a5, float a6, float a7) {
  u32x4 w = {cvt2(a0, a1), cvt2(a2, a3), cvt2(a4, a5), cvt2(a6, a7)}; return __builtin_bit_cast(bf16x8, w);
}

namespace pg8 {
constexpr int BM = 256, BK = 64, HALF = 128, HTB = HALF * BK * 2, STAGE_BYTES = 8 * HTB, NXCD = 8, WGM = 8;
DI int lds_byte(int r, int c) { const int st = (r >> 4) * 2 + (c >> 5), rr = r & 15, cc = c & 31, ob = rr * 64 + cc * 2; return st * 1024 + (ob ^ (((ob >> 9) & 1) << 5)); }
DI void stage_rc(int b, int& R, int& C) { const int st = b / 1024, sb = b % 1024, swz = sb ^ (((sb >> 9) & 1) << 5); R = (st >> 1) * 16 + swz / 64; C = (st & 1) * 32 + (swz % 64) / 2; }
DI int perm32(int rho) { const int n = rho >> 4, i = rho & 15; return 8 * (i >> 2) + 4 * n + (i & 3); }
struct Unit { int pm, pn; };
struct Gemm { const bf16_t* A; const bf16_t* Bt; int M, N, K; };
struct StaticOrder {
  int nM, nN, nwg, G, c;
  DI void init(int M, int N, int G_, int c_) { nM = M / BM; nN = N / BM; nwg = nM * nN; G = G_; c = c_; }
  DI bool next(int i, Unit& u) const {
    const long L = (long)i * G + c; if (L >= nwg) return false;
    int wgid = (int)L; { const int q = nwg / NXCD, r = nwg % NXCD, xcd = wgid % NXCD, off = wgid / NXCD; wgid = (xcd < r ? xcd * (q + 1) : r * (q + 1) + (xcd - r) * q) + off; }
    const int nig = WGM * nN, gid = wgid / nig, fm = gid * WGM, gsz = (nM - fm) < WGM ? (nM - fm) : WGM;
    u.pm = fm + ((wgid % nig) % gsz); u.pn = (wgid % nig) / gsz; return true;
  }
};
template <bool VSS> struct EpiBf16 {
  static constexpr bool PERM = true;
  bf16_t* O; int ldc; float* vss; const float* rstd;
  DI void operator()(const f32x4 (&acc)[2][2][4][2], const Unit& u, int wr, int wc, int fr, int fq) const {
    const int row0 = u.pm * BM + wr * 64 + fr; const int col0 = u.pn * BM + wc * 32 + 8 * fq;
    const bool dov = VSS && (u.pn >= 8) && (u.pn < 16);
#pragma unroll
    for (int ai = 0; ai < 2; ++ai)
#pragma unroll
      for (int m = 0; m < 4; ++m) {
        bf16_t* rowp = O + (size_t)(row0 + ai * HALF + m * 16) * ldc + col0; float ss = 0.f; const float rs = rstd[row0 + ai * HALF + m * 16];
#pragma unroll
        for (int bj = 0; bj < 2; ++bj) { const f32x4 v0 = acc[ai][bj][m][0] * rs, v1 = acc[ai][bj][m][1] * rs;
          u32x4 w; w.x = cvt2(v0[0], v0[1]); w.y = cvt2(v0[2], v0[3]); w.z = cvt2(v1[0], v1[1]); w.w = cvt2(v1[2], v1[3]);
          *(u32x4*)(rowp + bj * HALF) = w;
          if (VSS) { ss += v0[0] * v0[0] + v0[1] * v0[1] + v0[2] * v0[2] + v0[3] * v0[3] + v1[0] * v1[0] + v1[1] * v1[1] + v1[2] * v1[2] + v1[3] * v1[3]; } }
        if (VSS) { if (dov) { ss += __shfl_xor(ss, 16); ss += __shfl_xor(ss, 32); if (fq == 0) vss[(size_t)(row0 + ai * HALF + m * 16) * 32 + (u.pn - 8) * 4 + wc] = ss; } }
      }
  }
};
struct EpiRes {
  static constexpr bool PERM = false;
  float* out; const float* xin; int ldc; bf16_t* xb; float* xssp;
  DI void operator()(const f32x4 (&acc)[2][2][4][2], const Unit& u, int wr, int wc, int fr, int fq) const {
    const int row0 = u.pm * BM + wr * 64 + fr, col0 = u.pn * BM + wc * 32 + 4 * fq;
#pragma unroll
    for (int ai = 0; ai < 2; ++ai)
#pragma unroll
      for (int m = 0; m < 4; ++m) { const size_t ro = (size_t)(row0 + ai * HALF + m * 16) * ldc + col0; float ss = 0.f;
#pragma unroll
        for (int bj = 0; bj < 2; ++bj)
#pragma unroll
          for (int n = 0; n < 2; ++n) { const f32x4 xv = *(const f32x4*)(xin + ro + bj * HALF + n * 16); const f32x4 v = acc[ai][bj][m][n] + xv; *(f32x4*)(out + ro + bj * HALF + n * 16) = v;
            if (xb) { *(u32x2*)(xb + ro + bj * HALF + n * 16) = (u32x2){cvt2(v[0], v[1]), cvt2(v[2], v[3])}; ss += v[0] * v[0] + v[1] * v[1] + v[2] * v[2] + v[3] * v[3]; } }
        if (xb) { ss += __shfl_xor(ss, 16); ss += __shfl_xor(ss, 32); if (fq == 0) xssp[(size_t)(row0 + ai * HALF + m * 16) * 16 + u.pn * 4 + wc] = ss; } }
  }
};

template <class Epi>
DI void gemm_phase(LAS unsigned char* lds, const Gemm g, const StaticOrder& S, const Epi& E, int wv) {
  const int tid = tid_of(wv), wid = __builtin_amdgcn_readfirstlane(tid >> 6), lane = tid & 63, wr = wid >> 2, wc = wid & 3, fr = lane & 15, fq = lane >> 4;
  const int K = g.K, nt = K / BK;
  unsigned voffA[2], voffB[2];
#pragma unroll
  for (int i = 0; i < 2; ++i) { int R, C; stage_rc(tid * 16 + i * 8192, R, C); const int Rb = Epi::PERM ? ((R & ~31) + perm32(R & 31)) : R;
    voffA[i] = (unsigned)(R * K + C) * 2u; voffB[i] = (unsigned)(Rb * K + C) * 2u; }
  const size_t kstep = (size_t)(BK * 2);
  const size_t hstep = (size_t)HALF * K * 2;
  const size_t tstep = 2 * hstep;
  const unsigned ldsw = (unsigned)wid * 1024u;
  const int aoff = lds_byte(wr * 64 + fr, fq * 8), boff = lds_byte(wc * 32 + fr, fq * 8);
#define PG8_SA(b, h) (((b) * 2 + (h)) * HTB)
#define PG8_SB(b, h) ((4 + (b) * 2 + (h)) * HTB)
#define PG8_STAGE(bufoff, gbase, voff) do { _Pragma("unroll") for (int _i = 0; _i < 2; ++_i) \
    __builtin_amdgcn_global_load_lds((const unsigned*)((const char*)(gbase) + (voff)[_i]), (LAS unsigned*)(lds + (bufoff) + ldsw + _i * 8192), 16, 0, 0); } while (0)
#define PG8_LDA(dst, b, h) do { _Pragma("unroll") for (int m = 0; m < 4; ++m) _Pragma("unroll") for (int k = 0; k < 2; ++k) dst[m][k] = *(const LAS bf16x8*)(lds + PG8_SA(b, h) + aoff + m * 2048 + k * 1024); } while (0)
#define PG8_LDB(dst, b, h) do { _Pragma("unroll") for (int n = 0; n < 2; ++n) _Pragma("unroll") for (int k = 0; k < 2; ++k) dst[n][k] = *(const LAS bf16x8*)(lds + PG8_SB(b, h) + boff + n * 2048 + k * 1024); } while (0)
#define PG8_MMA(ai, bj, At, Bt) do { __builtin_amdgcn_s_setprio(1); _Pragma("unroll") for (int m = 0; m < 4; ++m) _Pragma("unroll") for (int n = 0; n < 2; ++n) _Pragma("unroll") for (int k = 0; k < 2; ++k) \
    acc[ai][bj][m][n] = __builtin_amdgcn_mfma_f32_16x16x32_bf16(Bt[n][k], At[m][k], acc[ai][bj][m][n], 0, 0, 0); __builtin_amdgcn_s_setprio(0); } while (0)
#define PG8_WAIT_V(n) asm volatile("s_waitcnt vmcnt(" #n ")" ::: "memory")
#define PG8_WAIT_L(n) asm volatile("s_waitcnt lgkmcnt(" #n ")" ::: "memory")
#define PG8_BAR __builtin_amdgcn_s_barrier()
#define PG8_SCHED __builtin_amdgcn_sched_barrier(0)
  Unit cur, nxt; int ui = 0;
  if (!S.next(0, cur)) return;
  f32x4 acc[2][2][4][2];
#pragma unroll
  for (int a = 0; a < 2; ++a)
#pragma unroll
    for (int b = 0; b < 2; ++b)
#pragma unroll
      for (int m = 0; m < 4; ++m)
#pragma unroll
        for (int n = 0; n < 2; ++n) acc[a][b][m][n] = (f32x4){0.f, 0.f, 0.f, 0.f};
  bf16x8 At[4][2], B0[2][2], B1[2][2];
  const char* cA = (const char*)g.A + (size_t)cur.pm * tstep; const char* cB = (const char*)g.Bt + (size_t)cur.pn * tstep;
  PG8_STAGE(PG8_SB(0, 0), cB, voffB); PG8_STAGE(PG8_SA(0, 0), cA, voffA); PG8_STAGE(PG8_SB(0, 1), cB + hstep, voffB); PG8_STAGE(PG8_SA(0, 1), cA + hstep, voffA);
  if (wr == 1) PG8_BAR;
  PG8_WAIT_V(4); PG8_BAR;
  PG8_STAGE(PG8_SB(1, 0), cB + kstep, voffB); PG8_STAGE(PG8_SA(1, 0), cA + kstep, voffA); PG8_STAGE(PG8_SB(1, 1), cB + hstep + kstep, voffB);
  PG8_WAIT_V(6); PG8_BAR;
  for (;;) {
    const bool has_next = S.next(ui + 1, nxt);
    const char* nA = has_next ? (const char*)g.A + (size_t)nxt.pm * tstep : cA; const char* nB = has_next ? (const char*)g.Bt + (size_t)nxt.pn * tstep : cB;
    for (int t = 0; t < nt; t += 2) {
      const bool last = (t == nt - 2);
      const char* a1 = cA + (size_t)(t + 1) * kstep;
      const char* a2 = last ? nA : cA + (size_t)(t + 2) * kstep; const char* b2 = last ? nB : cB + (size_t)(t + 2) * kstep;
      const char* a3 = a2 + kstep; const char* b3 = b2 + kstep;
      PG8_LDB(B0, 0, 0); PG8_SCHED; PG8_LDA(At, 0, 0); PG8_STAGE(PG8_SA(1, 1), a1 + hstep, voffA);
      PG8_WAIT_L(8); PG8_BAR; PG8_WAIT_L(0); PG8_MMA(0, 0, At, B0); PG8_BAR; PG8_SCHED;
      PG8_LDB(B1, 0, 1); PG8_STAGE(PG8_SB(0, 0), b2, voffB);
      PG8_BAR; PG8_WAIT_L(0); PG8_MMA(0, 1, At, B1); PG8_BAR;
      PG8_LDA(At, 0, 1); PG8_STAGE(PG8_SA(0, 0), a2, voffA);
      PG8_BAR; PG8_WAIT_L(0); PG8_MMA(1, 0, At, B0); PG8_BAR; PG8_SCHED;
      PG8_STAGE(PG8_SB(0, 1), b2 + hstep, voffB);
      PG8_WAIT_V(6); PG8_BAR; PG8_MMA(1, 1, At, B1); PG8_BAR;
      PG8_LDB(B0, 1, 0); PG8_SCHED; PG8_LDA(At, 1, 0); PG8_STAGE(PG8_SA(0, 1), a2 + hstep, voffA);
      PG8_WAIT_L(8); PG8_BAR; PG8_WAIT_L(0); PG8_MMA(0, 0, At, B0); PG8_BAR; PG8_SCHED;
      PG8_LDB(B1, 1, 1); PG8_STAGE(PG8_SB(1, 0), b3, voffB);
      PG8_BAR; PG8_WAIT_L(0); PG8_MMA(0, 1, At, B1); PG8_BAR;
      PG8_LDA(At, 1, 1); PG8_STAGE(PG8_SA(1, 0), a3, voffA);
      PG8_BAR; PG8_WAIT_L(0); PG8_MMA(1, 0, At, B0); PG8_BAR; PG8_SCHED;
      PG8_STAGE(PG8_SB(1, 1), b3 + hstep, voffB);
      PG8_WAIT_V(6); PG8_BAR; PG8_MMA(1, 1, At, B1); PG8_BAR;
    }
    E(acc, cur, wr, wc, fr, fq);
    if (!has_next) break;
#pragma unroll
    for (int a = 0; a < 2; ++a)
#pragma unroll
      for (int b = 0; b < 2; ++b)
#pragma unroll
        for (int m = 0; m < 4; ++m)
#pragma unroll
          for (int n = 0; n < 2; ++n) acc[a][b][m][n] = (f32x4){0.f, 0.f, 0.f, 0.f};
    cur = nxt; cA = nA; cB = nB; ++ui;
  }
  PG8_WAIT_V(0);
  if (wr == 0) PG8_BAR;
  PG8_BAR;
#undef PG8_SA
#undef PG8_SB
#undef PG8_STAGE
#undef PG8_LDA
#undef PG8_LDB
#undef PG8_MMA
#undef PG8_WAIT_V
#undef PG8_WAIT_L
#undef PG8_BAR
#undef PG8_SCHED
}
}

template <class Epi> DI void run_gemm(unsigned char* smem, const bf16_t* A, const bf16_t* Bt, int M, int N, int K, const Epi& E, int wv) {
  pg8::Gemm g{A, Bt, M, N, K}; pg8::StaticOrder S; S.init(M, N, (int)gridDim.x, (int)blockIdx.x);
  pg8::gemm_phase<Epi>((LAS unsigned char*)smem, g, S, E, wv);
  __syncthreads();
}

DI const float* xrow_in(const Params& p, int layer, int row) {
  if (layer == 0) return row < 2 * SEQ ? p.x_prompt + (size_t)row * DM : p.x_sample + (size_t)(row - 2 * SEQ) * DM;
  return p.out + (size_t)row * DM;
}
DI void norm_rows(const Params& p, int layer, int wv) {
  const int tidq = tid_of(wv), wid = tidq >> 6, lane = tidq & 63;
  bf16_t* xb = (bf16_t*)(p.ws + WS_XB); float* rstd = (float*)(p.ws + WS_RSTD);
  for (int row = blockIdx.x * 8 + wid; row < NTOK; row += gridDim.x * 8) {
    const float* xr = xrow_in(p, layer, row);
    f32x4 v[4]; float ss = 0.f;
#pragma unroll
    for (int i = 0; i < 4; ++i) { v[i] = *(const f32x4*)(xr + i * 256 + lane * 4); ss += v[i][0] * v[i][0] + v[i][1] * v[i][1] + v[i][2] * v[i][2] + v[i][3] * v[i][3]; }
    ss = wave_sum(ss);
    if (lane == 0) rstd[row] = rsqrtf(ss * (1.f / DM) + EPS);
#pragma unroll
    for (int i = 0; i < 4; ++i) { u32x2 w = {cvt2(v[i][0], v[i][1]), cvt2(v[i][2], v[i][3])}; *(u32x2*)(xb + (size_t)row * DM + i * 256 + lane * 4) = w; }
  }
}
DI void rstd_rows(const Params& p, int wv) {
  const int tid = tid_of(wv);
  const float* xs = (const float*)(p.ws + WS_XSSP); float* rstd = (float*)(p.ws + WS_RSTD);
  for (int row = blockIdx.x * 512 + tid; row < NTOK; row += gridDim.x * 512) {
    const f32x4* vp = (const f32x4*)(xs + (size_t)row * 16); const f32x4 a = (vp[0] + vp[1]) + (vp[2] + vp[3]);
    rstd[row] = rsqrtf(((a[0] + a[1]) + (a[2] + a[3])) * (1.f / DM) + EPS); }
}
DI void conv_weight_T(unsigned char* smem, const float* W, int K, int N, int Npad, bf16_t* Bt, const float* gk, int nscale, float cscale, int wv) {
  float* tile = (float*)smem;
  const int tid = tid_of(wv), ntn = Npad / 64, ntk = K / 64, ntiles = ntn * ntk;
  for (int t = blockIdx.x; t < ntiles; t += gridDim.x) {
    const int kt = t % ntk, nt = t / ntk, k0 = kt * 64, n0 = nt * 64;
    __syncthreads();
#pragma unroll
    for (int i = 0; i < 2; ++i) {
      const int kk = (tid >> 4) + 32 * i, nn = (tid & 15) * 4; const float gs = gk ? gk[k0 + kk] : 1.f;
      f32x4 wv4 = {0.f, 0.f, 0.f, 0.f}; if (n0 + nn < N) wv4 = *(const f32x4*)(W + (size_t)(k0 + kk) * N + n0 + nn);
      const float cs = gs * (n0 + nn < nscale ? cscale : 1.f);
#pragma unroll
      for (int e = 0; e < 4; ++e) tile[kk * 65 + nn + e] = wv4[e] * cs;
    }
    __syncthreads();
    const int n = tid >> 3, k8 = (tid & 7) * 8;
    float a[8];
#pragma unroll
    for (int e = 0; e < 8; ++e) a[e] = tile[(k8 + e) * 65 + n];
    *(bf16x8*)(Bt + (size_t)(n0 + n) * K + k0 + k8) = pack8(a[0], a[1], a[2], a[3], a[4], a[5], a[6], a[7]);
  }
  __syncthreads();
}

DI void sgu_phase(const Params& p, unsigned char* smem, int seq, int j, int wv) {
  constexpr int RS = 576, SVS = 528;
  const int tid = tid_of(wv), wid = tid >> 6, lane = tid & 63, r32 = lane & 31, hi = lane >> 5;
  const bf16_t* UVZ = (const bf16_t*)(p.ws + WS_ACT); bf16_t* Y = (bf16_t*)(p.ws + WS_Y);
  const float* vss = (const float*)(p.ws + WS_VSS); float* rv_l = (float*)(smem + 128 * RS);
  const float* w_s = p.a_w_s + (size_t)j * 8 * 128 * 128; const float* b_s = p.a_b_s + (size_t)j * 8 * 128; const float* v_g = p.a_v_g + (size_t)j * DIN;
  const unsigned img = (unsigned)(size_t)(LAS unsigned char*)smem;
  const int qt = wid & 3, ch = wid >> 2;
  const int q4 = (lane & 15) >> 2, p4 = lane & 3, blk = (lane >> 4) & 1;
  bf16x8 af[8]; int g_loaded = -1;
#pragma unroll
  for (int s = 0; s < 8; ++s) af[s] = (bf16x8){};
  for (int item = blockIdx.x; item < 1024; item += gridDim.x) {
    const int n = item >> 3, g = item & 7, tok0 = n * 128;
    __syncthreads();
    if (tid < 128) { const f32x4* vp = (const f32x4*)(vss + (size_t)(tok0 + tid) * 32); f32x4 a = vp[0];
#pragma unroll
      for (int k = 1; k < 8; ++k) a += vp[k];
      rv_l[tid] = rsqrtf(((a[0] + a[1]) + (a[2] + a[3])) * (1.f / DIN) + EPS); }
    __syncthreads();
    { const int cg8 = (tid & 31) * 8; float gv[8];
#pragma unroll
      for (int e = 0; e < 8; ++e) gv[e] = v_g[g * 256 + cg8 + e];
#pragma unroll
      for (int i = 0; i < 8; ++i) { const int pp = (tid >> 5) + 16 * i; const float rv = rv_l[pp];
        const u32x4 w = *(const u32x4*)(UVZ + (size_t)(tok0 + pp) * NA + 2048 + g * 256 + cg8);
        const bf16x8 o = pack8(bflo(w.x) * rv * gv[0], bfhi(w.x) * rv * gv[1], bflo(w.y) * rv * gv[2], bfhi(w.y) * rv * gv[3], bflo(w.z) * rv * gv[4], bfhi(w.z) * rv * gv[5], bflo(w.w) * rv * gv[6], bfhi(w.w) * rv * gv[7]);
        *(bf16x8*)(smem + pp * RS + cg8 * 2) = o; } }
    if (g != g_loaded) { g_loaded = g;
      const float* wr_ = w_s + ((size_t)g * 128 + qt * 32 + r32) * 128 + hi * 8;
#pragma unroll
      for (int s = 0; s < 8; ++s) { const f32x4 a = *(const f32x4*)(wr_ + s * 16), b = *(const f32x4*)(wr_ + s * 16 + 4); af[s] = pack8(a[0], a[1], a[2], a[3], b[0], b[1], b[2], b[3]); } }
    __syncthreads();
    f32x16 acc[4];
#pragma unroll
    for (int cb = 0; cb < 4; ++cb) { acc[cb] = (f32x16){};
      const unsigned base = img + (8 * hi + q4) * RS + (128 * ch + 32 * cb + 16 * blk + 4 * p4) * 2;
      s16x4 lo[8], hh[8];
#pragma unroll
      for (int s = 0; s < 8; ++s) { lo[s] = tr_read0(base + 16 * s * RS); hh[s] = tr_read0(base + (16 * s + 4) * RS); }
      LGKM0(); SBAR();
#pragma unroll
      for (int s = 0; s < 8; ++s) acc[cb] = MFMA32(af[s], PK8(lo[s], hh[s]), acc[cb]);
    }
    { unsigned char* sv_l = smem + 128 * RS + 512;
#pragma unroll
      for (int i = 0; i < 16; ++i) { const int q = qt * 32 + crow(i, hi); const float bs = b_s[g * 128 + q];
#pragma unroll
        for (int cb = 0; cb < 4; ++cb) *(bf16_t*)(sv_l + q * SVS + (ch * 128 + cb * 32 + r32) * 2) = f2bf(acc[cb][i] + bs); }
      __syncthreads();
#pragma unroll
      for (int i = 0; i < 8; ++i) { const int q = (tid >> 5) + 16 * i, c8 = (tid & 31) * 8; const size_t ro = (size_t)(tok0 + q) * NA + g * 256 + c8;
        const u32x4 sv = *(const u32x4*)(sv_l + q * SVS + c8 * 2), u = *(const u32x4*)(UVZ + ro), z = *(const u32x4*)(UVZ + ro + 4096);
        *(bf16x8*)(Y + (size_t)(tok0 + q) * DIN + g * 256 + c8) = pack8(
          bflo(u.x) * bflo(sv.x) * silu(bflo(z.x)), bfhi(u.x) * bfhi(sv.x) * silu(bfhi(z.x)), bflo(u.y) * bflo(sv.y) * silu(bflo(z.y)), bfhi(u.y) * bfhi(sv.y) * silu(bfhi(z.y)),
          bflo(u.z) * bflo(sv.z) * silu(bflo(z.z)), bfhi(u.z) * bfhi(sv.z) * silu(bfhi(z.z)), bflo(u.w) * bflo(sv.w) * silu(bflo(z.w)), bfhi(u.w) * bfhi(sv.w) * silu(bfhi(z.w))); } }
  }
  __syncthreads();
}

constexpr size_t B_QT = 168 * MiB, B_KT = 200 * MiB, B_OB = 232 * MiB;
DI int gla_pos(int dir, int tau) { return dir ? (SEQ - 1 - tau) : tau; }
DI void gla_prep_phase(const Params& p, unsigned char* smem, int jb, int wv) {
  float* a_l = (float*)smem; float* seg_l = (float*)(smem + 4096); float* rl_l = (float*)(smem + 6144);
  const int tid = tid_of(wv);
  const bf16_t* X = (const bf16_t*)(p.ws + WS_ACT);
  bf16_t* QT = (bf16_t*)(p.ws + WS_ACT + B_QT); bf16_t* KT = (bf16_t*)(p.ws + WS_ACT + B_KT);
  float* Ev = (float*)(p.ws + WS_GLAE);
  for (int item = blockIdx.x; item < 2048; item += gridDim.x) {
    const int chunk = item & 255, hd = (item >> 8) & 3, dir = item >> 10, tau0 = chunk * 64;
    __syncthreads();
    if (tid < 128) { const int t = tid >> 1, hf = tid & 1; const int pos = gla_pos(dir, tau0 + t);
      const u32x4 w = *(const u32x4*)(X + (size_t)pos * NB + 5120 + dir * 16 + hf * 8);
      float* d = a_l + t * 16 + hf * 8; d[0] = bflo(w.x); d[1] = bfhi(w.x); d[2] = bflo(w.y); d[3] = bfhi(w.y); d[4] = bflo(w.z); d[5] = bfhi(w.z); d[6] = bflo(w.w); d[7] = bfhi(w.w); }
    const int d = tid & 127, tq = tid >> 7;
    float qv[16], kv[16];
#pragma unroll
    for (int tt = 0; tt < 16; ++tt) { const int pos = gla_pos(dir, tau0 + tq * 16 + tt);
      qv[tt] = bf2f(X[(size_t)pos * NB + hd * 128 + d]); kv[tt] = bf2f(X[(size_t)pos * NB + 512 + hd * 128 + d]); }
    float wg[16];
#pragma unroll
    for (int r = 0; r < 16; ++r) wg[r] = p.b_w_gate[(((size_t)jb * 2 + dir) * 16 + r) * 512 + hd * 128 + d];
    const float gb = p.b_gate_bias[((size_t)jb * 2 + dir) * 512 + hd * 128 + d];
    __syncthreads();
    float cum[16]; float run = 0.f;
#pragma unroll
    for (int tt = 0; tt < 16; ++tt) { const float* ar = a_l + (tq * 16 + tt) * 16; float pre = gb;
#pragma unroll
      for (int r = 0; r < 16; ++r) pre += ar[r] * wg[r];
      const float ls = fminf(pre, 0.f) - __logf(1.f + __expf(-fabsf(pre)));
      run += ls * (1.f / 16.f); cum[tt] = run; }
    seg_l[tq * 128 + d] = run;
    __syncthreads();
    float off = 0.f;
    for (int q = 0; q < tq; ++q) off += seg_l[q * 128 + d];
#pragma unroll
    for (int tt = 0; tt < 16; ++tt) cum[tt] += off;
    if (tq == 2) rl_l[d] = cum[0];
    if (tq == 3) rl_l[128 + d] = cum[15];
    __syncthreads();
    const float ref = rl_l[d], last = rl_l[128 + d];
    if (tq == 0) { float* e = Ev + ((((size_t)dir * 4 + hd) * 256 + chunk) * 3) * 128; e[d] = __expf(ref); e[128 + d] = __expf(last - ref); e[256 + d] = __expf(last); }
    unsigned char* qt_l = smem + 8192; unsigned char* kt_l = smem + 8192 + 64 * 272;
#pragma unroll
    for (int tt = 0; tt < 16; ++tt) { const int t = tq * 16 + tt;
      *(bf16_t*)(qt_l + t * 272 + d * 2) = f2bf(qv[tt] * __expf(cum[tt] - ref)); *(bf16_t*)(kt_l + t * 272 + d * 2) = f2bf(kv[tt] * __expf(ref - cum[tt])); }
    __syncthreads();
    { const size_t gb0 = (((size_t)dir * 4 + hd) * SEQ + tau0) * 128;
#pragma unroll
      for (int i = 0; i < 2; ++i) { const int idx = tid + 512 * i, row = idx >> 4, c16 = idx & 15;
        *(u32x4*)(QT + gb0 + row * 128 + c16 * 8) = *(const u32x4*)(qt_l + row * 272 + c16 * 16); *(u32x4*)(KT + gb0 + row * 128 + c16 * 8) = *(const u32x4*)(kt_l + row * 272 + c16 * 16); } }
  }
  __syncthreads();
}

DI void gla_chain_phase(const Params& p, unsigned char* smem, int wv) {
  constexpr int RSQ = 272, RSK = 320, RSV = 80, STB = 44544, PRB = 6 * 4096;
  constexpr int OQ = 0, OK = 17408, OV = 37888, OE = 43008;
  const int tid = tid_of(wv), wid = __builtin_amdgcn_readfirstlane(tid >> 6), lane = tid & 63, r32 = lane & 31, hi = lane >> 5;
  const int q4 = (lane & 15) >> 2, p4 = lane & 3, blk = (lane >> 4) & 1;
  const unsigned lbase = (unsigned)(size_t)(LAS unsigned char*)smem;
  const bf16_t* X = (const bf16_t*)(p.ws + WS_ACT);
  const bf16_t* QT = (const bf16_t*)(p.ws + WS_ACT + B_QT); const bf16_t* KT = (const bf16_t*)(p.ws + WS_ACT + B_KT);
  const float* Ev = (const float*)(p.ws + WS_GLAE);
  for (int chain = blockIdx.x; chain < 128; chain += gridDim.x) {
    const int slice = (chain >> 3) & 15, hd = chain & 3, dir = (chain >> 2) & 1, vc0 = hd * 512 + slice * 32;
    bf16_t* Od = (bf16_t*)(dir ? (p.ws + WS_ACT + B_OB) : (p.ws + WS_Y));
    __syncthreads();
    if (wid >= 4) {
      const int tp = tid - 256;
      const bf16_t* qsrc = QT + ((size_t)dir * 4 + hd) * SEQ * 128; const bf16_t* ksrc = KT + ((size_t)dir * 4 + hd) * SEQ * 128;
      const float* esrc = Ev + (((size_t)dir * 4 + hd) * 256) * 384;
      u32x4 rq[4], rk[4], rv, re;
      auto gload = [&](int chunk) {
#pragma unroll
        for (int i = 0; i < 4; ++i) { const int idx = tp + 256 * i; rq[i] = *(const u32x4*)(qsrc + (size_t)chunk * 64 * 128 + idx * 8); rk[i] = *(const u32x4*)(ksrc + (size_t)chunk * 64 * 128 + idx * 8); }
        rv = *(const u32x4*)(X + (size_t)gla_pos(dir, chunk * 64 + (tp >> 2)) * NB + 1024 + vc0 + (tp & 3) * 8);
        if (tp < 96) re = *(const u32x4*)(esrc + (size_t)chunk * 384 + tp * 4);
      };
      auto lwrite = [&](int b) { unsigned char* bb = smem + b * STB;
#pragma unroll
        for (int i = 0; i < 4; ++i) { const int idx = tp + 256 * i, row = idx >> 4, c16 = idx & 15; *(u32x4*)(bb + OQ + row * RSQ + c16 * 16) = rq[i]; *(u32x4*)(bb + OK + row * RSK + c16 * 16) = rk[i]; }
        *(u32x4*)(bb + OV + (tp >> 2) * RSV + (tp & 3) * 16) = rv;
        if (tp < 96) *(u32x4*)(bb + OE + tp * 16) = re;
      };
      auto finish = [&](int cc) { const unsigned char* pb = smem + 2 * STB + (cc & 1) * PRB; const int t = tp >> 2, v8 = (tp & 3) * 8;
        float acc[8] = {0.f, 0.f, 0.f, 0.f, 0.f, 0.f, 0.f, 0.f};
#pragma unroll
        for (int w = 0; w < 6; ++w) { if (w == 5 && t < 32) continue;
          const u32x4 pw = *(const u32x4*)(pb + ((w * 64 + t) * 32 + v8) * 2);
          acc[0] += bflo(pw.x); acc[1] += bfhi(pw.x); acc[2] += bflo(pw.y); acc[3] += bfhi(pw.y); acc[4] += bflo(pw.z); acc[5] += bfhi(pw.z); acc[6] += bflo(pw.w); acc[7] += bfhi(pw.w); }
        *(bf16x8*)(Od + (size_t)gla_pos(dir, cc * 64 + t) * DIN + vc0 + v8) = pack8(acc[0], acc[1], acc[2], acc[3], acc[4], acc[5], acc[6], acc[7]); };
      auto intra = [&](int c) { const int a = (wid == 6) ? 1 : 0, b = (wid == 4) ? 0 : 1;
        const unsigned char* bb = smem + (c & 1) * STB; unsigned char* pb = smem + 2 * STB + (c & 1) * PRB;
        f32x16 x = {};
#pragma unroll
        for (int ks = 0; ks < 8; ++ks) { const int cb = (16 * ks + 8 * hi) * 2;
          const bf16x8 kf = *(const bf16x8*)(bb + OK + (32 * a + r32) * RSK + cb), qf = *(const bf16x8*)(bb + OQ + (32 * b + r32) * RSQ + cb);
          x = MFMA32(kf, qf, x); if ((ks & 3) == 3) SBAR(); }
        if (a == b) {
#pragma unroll
          for (int i = 0; i < 16; ++i) { const int sidx = crow(i, hi); const bool keep = dir ? (sidx < r32) : (sidx <= r32); x[i] = keep ? x[i] : 0.f; } }
        bf16x8 pf[2];
#pragma unroll
        for (int st = 0; st < 2; ++st) pf[st] = pack8(x[8 * st], x[8 * st + 1], x[8 * st + 2], x[8 * st + 3], x[8 * st + 4], x[8 * st + 5], x[8 * st + 6], x[8 * st + 7]);
        const unsigned vb_ = lbase + (c & 1) * STB + OV + (32 * a + 4 * hi + q4) * RSV + (16 * blk + 4 * p4) * 2;
        s16x4 lo[2], hh[2];
#pragma unroll
        for (int st = 0; st < 2; ++st) { lo[st] = tr_read0(vb_ + (16 * st) * RSV); hh[st] = tr_read0(vb_ + (16 * st + 8) * RSV); }
        LGKM0(); SBAR();
        f32x16 z = {};
        z = MFMA32(pf[0], PK8(lo[0], hh[0]), z); z = MFMA32(pf[1], PK8(lo[1], hh[1]), z);
        const int slot = 4 + a;
#pragma unroll
        for (int i = 0; i < 16; ++i) *(bf16_t*)(pb + ((slot * 64 + 32 * b + crow(i, hi)) * 32 + r32) * 2) = f2bf(z[i]);
      };
      gload(0); lwrite(0); gload(1);
      __syncthreads();
      for (int c = 0; c < 256; ++c) {
        if (c + 1 < 256) { lwrite((c + 1) & 1); if (c + 2 < 256) gload(c + 2); }
        if (c > 0) finish(c - 1);
        if (wid < 7) intra(c);
        __syncthreads();
      }
      finish(255);
    } else {
      const int w = wid;
      f32x16 S = {};
      __syncthreads();
      for (int c = 0; c < 256; ++c) {
        const unsigned char* bb = smem + (c & 1) * STB; const float* e_l = (const float*)(bb + OE); unsigned char* pb = smem + 2 * STB + (c & 1) * PRB;
        float sc[16];
#pragma unroll
        for (int i = 0; i < 16; ++i) sc[i] = S[i] * e_l[32 * w + crow(i, hi)];
        f32x16 y0 = {}, y1 = {};
#pragma unroll
        for (int st = 0; st < 2; ++st) {
          const bf16x8 sb = pack8(sc[8 * st], sc[8 * st + 1], sc[8 * st + 2], sc[8 * st + 3], sc[8 * st + 4], sc[8 * st + 5], sc[8 * st + 6], sc[8 * st + 7]);
          const int dof = (32 * w + 16 * st + 4 * hi) * 2;
          const s16x4 a0l = *(const s16x4*)(bb + OQ + r32 * RSQ + dof), a0h = *(const s16x4*)(bb + OQ + r32 * RSQ + dof + 16);
          const s16x4 a1l = *(const s16x4*)(bb + OQ + (32 + r32) * RSQ + dof), a1h = *(const s16x4*)(bb + OQ + (32 + r32) * RSQ + dof + 16);
          y0 = MFMA32(PK8(a0l, a0h), sb, y0); y1 = MFMA32(PK8(a1l, a1h), sb, y1);
        }
        SBAR();
        f32x16 U = {};
        { const unsigned ka = lbase + (c & 1) * STB + OK + (8 * hi + q4) * RSK + (32 * w + 16 * blk + 4 * p4) * 2, va = lbase + (c & 1) * STB + OV + (8 * hi + q4) * RSV + (16 * blk + 4 * p4) * 2;
          s16x4 al[4], ah[4], bl[4], bh[4];
#pragma unroll
          for (int ks = 0; ks < 4; ++ks) { al[ks] = tr_read0(ka + (16 * ks) * RSK); ah[ks] = tr_read0(ka + (16 * ks + 4) * RSK); bl[ks] = tr_read0(va + (16 * ks) * RSV); bh[ks] = tr_read0(va + (16 * ks + 4) * RSV); }
          LGKM0(); SBAR();
#pragma unroll
          for (int ks = 0; ks < 4; ++ks) U = MFMA32(PK8(al[ks], ah[ks]), PK8(bl[ks], bh[ks]), U); }
#pragma unroll
        for (int i = 0; i < 16; ++i) { *(bf16_t*)(pb + ((w * 64 + crow(i, hi)) * 32 + r32) * 2) = f2bf(y0[i]); *(bf16_t*)(pb + ((w * 64 + 32 + crow(i, hi)) * 32 + r32) * 2) = f2bf(y1[i]); }
        SBAR();
#pragma unroll
        for (int i = 0; i < 16; ++i) { const int dd = 32 * w + crow(i, hi); S[i] = S[i] * e_l[256 + dd] + U[i] * e_l[128 + dd]; }
        __syncthreads();
      }
    }
  }
  __syncthreads();
}

DI void gla_post_phase(const Params& p, int jb, int wv) {
  const int tidq = tid_of(wv), wid = tidq >> 6, lane = tidq & 63;
  const bf16_t* X = (const bf16_t*)(p.ws + WS_ACT); bf16_t* Y = (bf16_t*)(p.ws + WS_Y); const bf16_t* OB = (const bf16_t*)(p.ws + WS_ACT + B_OB);
  const float* og = p.b_o_g + (size_t)jb * 512;
  float gg[8];
#pragma unroll
  for (int e = 0; e < 8; ++e) gg[e] = og[lane * 8 + e];
  for (int it0 = blockIdx.x * 8 + wid; it0 < SEQ * 4; it0 += gridDim.x * 8 * 4) {
    u32x4 a[4], b[4], g[4];
#pragma unroll
    for (int u = 0; u < 4; ++u) { const int it = it0 + u * gridDim.x * 8; if (it < SEQ * 4) { const int tok = it >> 2, hd = it & 3; const size_t o = (size_t)tok * DIN + hd * 512 + lane * 8;
        a[u] = *(const u32x4*)(Y + o); b[u] = *(const u32x4*)(OB + o); g[u] = *(const u32x4*)(X + (size_t)tok * NB + 3072 + hd * 512 + lane * 8); } }
#pragma unroll
    for (int u = 0; u < 4; ++u) { const int it = it0 + u * gridDim.x * 8; if (it < SEQ * 4) { const int tok = it >> 2, hd = it & 3; const size_t o = (size_t)tok * DIN + hd * 512 + lane * 8;
        float v[8] = {bflo(a[u].x) + bflo(b[u].x), bfhi(a[u].x) + bfhi(b[u].x), bflo(a[u].y) + bflo(b[u].y), bfhi(a[u].y) + bfhi(b[u].y), bflo(a[u].z) + bflo(b[u].z), bfhi(a[u].z) + bfhi(b[u].z), bflo(a[u].w) + bflo(b[u].w), bfhi(a[u].w) + bfhi(b[u].w)};
        const float gv[8] = {bflo(g[u].x), bfhi(g[u].x), bflo(g[u].y), bfhi(g[u].y), bflo(g[u].z), bfhi(g[u].z), bflo(g[u].w), bfhi(g[u].w)};
        float ss = 0.f;
#pragma unroll
        for (int e = 0; e < 8; ++e) ss += v[e] * v[e];
        ss = wave_sum(ss); const float r = rsqrtf(ss * (1.f / 512.f) + EPS);
#pragma unroll
        for (int e = 0; e < 8; ++e) v[e] = v[e] * r * gg[e] * silu(gv[e]);
        *(bf16x8*)(Y + o) = pack8(v[0], v[1], v[2], v[3], v[4], v[5], v[6], v[7]); } }
  }
}

DI void qknorm_phase(const Params& p, unsigned char* smem, int jc, int wv) {
  const int tidq = tid_of(wv), wid = tidq >> 6, lane = tidq & 63, sub = lane >> 4, l16 = lane & 15;
  bf16_t* X = (bf16_t*)(p.ws + WS_ACT);
  float gq[8], gk[8];
#pragma unroll
  for (int e = 0; e < 8; ++e) { gq[e] = p.c_q_g[(size_t)jc * 128 + l16 * 8 + e] * (0.08838834764831845f * 1.4426950408889634f); gk[e] = p.c_k_g[(size_t)jc * 128 + l16 * 8 + e]; }
  float mq = 0.f, mk = 0.f;
  for (int it0 = blockIdx.x * 8 + wid; it0 < SEQ * 8; it0 += gridDim.x * 8 * 4) {
    u32x4 w4[4];
#pragma unroll
    for (int u = 0; u < 4; ++u) { const int it = it0 + u * gridDim.x * 8; if (it < SEQ * 8) { const int row = it >> 3, gi = (it & 7) * 4 + sub; w4[u] = *(const u32x4*)(X + (size_t)row * NC + gi * 128 + l16 * 8); } }
#pragma unroll
    for (int u = 0; u < 4; ++u) { const int it = it0 + u * gridDim.x * 8; if (it < SEQ * 8) { const int row = it >> 3, gi = (it & 7) * 4 + sub;
        bf16_t* ptr = X + (size_t)row * NC + gi * 128 + l16 * 8; const u32x4 w = w4[u];
        float v[8] = {bflo(w.x), bfhi(w.x), bflo(w.y), bfhi(w.y), bflo(w.z), bfhi(w.z), bflo(w.w), bfhi(w.w)};
        float ss = 0.f;
#pragma unroll
        for (int e = 0; e < 8; ++e) ss += v[e] * v[e];
        ss += __shfl_xor(ss, 1); ss += __shfl_xor(ss, 2); ss += __shfl_xor(ss, 4); ss += __shfl_xor(ss, 8);
        const float r = rsqrtf(ss * (1.f / 128.f) + EPS); const bool isq = gi < 16;
#pragma unroll
        for (int e = 0; e < 8; ++e) v[e] = v[e] * r * (isq ? gq[e] : gk[e]);
        const bf16x8 ov = pack8(v[0], v[1], v[2], v[3], v[4], v[5], v[6], v[7]);
        *(bf16x8*)ptr = ov;
        { const u32x4 ow = __builtin_bit_cast(u32x4, ov);
          float n2 = bflo(ow.x) * bflo(ow.x) + bfhi(ow.x) * bfhi(ow.x) + bflo(ow.y) * bflo(ow.y) + bfhi(ow.y) * bfhi(ow.y) + bflo(ow.z) * bflo(ow.z) + bfhi(ow.z) * bfhi(ow.z) + bflo(ow.w) * bflo(ow.w) + bfhi(ow.w) * bfhi(ow.w);
          n2 += __shfl_xor(n2, 1); n2 += __shfl_xor(n2, 2); n2 += __shfl_xor(n2, 4); n2 += __shfl_xor(n2, 8);
          if (isq) mq = fmaxf(mq, n2); else mk = fmaxf(mk, n2); } } }
  }
  { float* red = (float*)smem;
    mq = fmaxf(mq, __shfl_xor(mq, 16)); mq = fmaxf(mq, __shfl_xor(mq, 32)); mk = fmaxf(mk, __shfl_xor(mk, 16)); mk = fmaxf(mk, __shfl_xor(mk, 32));
    __syncthreads();
    if (lane == 0) { red[wid] = mq; red[8 + wid] = mk; }
    __syncthreads();
    if (tidq == 0) { float a = red[0], b = red[8];
      for (int i = 1; i < 8; ++i) { a = fmaxf(a, red[i]); b = fmaxf(b, red[8 + i]); }
      unsigned* nm = (unsigned*)(p.ws + WS_CTR) + 16;
      atomicMax(nm, __float_as_uint(a)); atomicMax(nm + 1, __float_as_uint(b)); }
    __syncthreads(); }
}

#define KSWZ(row, colB) ((row) * 256 + ((colB) ^ (((row) & 7) << 4)))
DI int v_rd_base(int lane) { return ((lane & 3) << 3) | (((lane >> 2) & 3) << 6) | (((lane >> 4) & 1) << 5) | (((lane >> 5) & 1) << 8); }
constexpr int v_rd_off(int d0, int ks, int half) { return d0 * 512 + ks * 4096 + half * 2048; }

template <int D0, int KH> DI void pv_half(f32x16& od, int vb, bf16x8 pa0, bf16x8 pa1) {
  const s16x4 l0 = tr_read<v_rd_off(D0, 2 * KH, 0)>(vb), h0 = tr_read<v_rd_off(D0, 2 * KH, 1)>(vb), l1 = tr_read<v_rd_off(D0, 2 * KH + 1, 0)>(vb), h1 = tr_read<v_rd_off(D0, 2 * KH + 1, 1)>(vb);
  LGKM0(); SBAR();
  od = MFMA32(pa0, PK8(l0, h0), od); od = MFMA32(pa1, PK8(l1, h1), od);
}
#define PV_RD(S, D0, VB) S##0 = tr_read<v_rd_off(D0, 2 * KH, 0)>(VB); S##1 = tr_read<v_rd_off(D0, 2 * KH, 1)>(VB); S##2 = tr_read<v_rd_off(D0, 2 * KH + 1, 0)>(VB); S##3 = tr_read<v_rd_off(D0, 2 * KH + 1, 1)>(VB)
#define PV_MM(S, OD) OD = MFMA32(pa0, PK8(S##0, S##1), OD); OD = MFMA32(pa1, PK8(S##2, S##3), OD)
#define PV_W4() asm volatile("s_waitcnt lgkmcnt(4)" ::: "memory"); SBAR()
template <int KH> DI void pv_pipe(f32x16 (&o)[8], int vb0, int vb1, bf16x8 pa0, bf16x8 pa1) {
  s16x4 a0, a1, a2, a3, b0, b1, b2, b3;
  PV_RD(a, 0, vb0);
  PV_RD(b, 1, vb0); PV_W4(); PV_MM(a, o[0]);
  PV_RD(a, 2, vb0); PV_W4(); PV_MM(b, o[1]);
  PV_RD(b, 3, vb0); PV_W4(); PV_MM(a, o[2]);
  PV_RD(a, 0, vb1); PV_W4(); PV_MM(b, o[3]);
  PV_RD(b, 1, vb1); PV_W4(); PV_MM(a, o[4]);
  PV_RD(a, 2, vb1); PV_W4(); PV_MM(b, o[5]);
  PV_RD(b, 3, vb1); PV_W4(); PV_MM(a, o[6]);
  LGKM0(); SBAR(); PV_MM(b, o[7]);
}
#undef PV_RD
#undef PV_MM
#undef PV_W4
DI void sm_half(f32x16& p0, float base, float slope2, float& l_reg, bf16x8& pa0, bf16x8& pa1) {
#pragma unroll
  for (int r = 0; r < 16; ++r) { const float dl = (float)((r & 3) + 8 * (r >> 2)); p0[r] = __builtin_amdgcn_exp2f(fmaf(-slope2, fabsf(base - dl), p0[r])); }
  float ps = 0.f;
#pragma unroll
  for (int r = 0; r < 16; ++r) ps += p0[r];
  { auto rr = __builtin_amdgcn_permlane32_swap(__float_as_uint(ps), __float_as_uint(ps), false, false);
    ps = __uint_as_float(rr[0]) + __uint_as_float(rr[1]); }
  l_reg += ps;
#define PK4(P, BASE, OUT) do { unsigned a0 = cvt2(P[BASE + 0], P[BASE + 1]), a1 = cvt2(P[BASE + 2], P[BASE + 3]); \
    unsigned b0 = cvt2(P[BASE + 4], P[BASE + 5]), b1 = cvt2(P[BASE + 6], P[BASE + 7]); \
    auto r0 = __builtin_amdgcn_permlane32_swap(a0, b0, false, false); auto r1 = __builtin_amdgcn_permlane32_swap(a1, b1, false, false); \
    u32x4 w = {r0[0], r1[0], r0[1], r1[1]}; OUT = __builtin_bit_cast(bf16x8, w); } while (0)
  PK4(p0, 0, pa0); PK4(p0, 8, pa1);
#undef PK4
}
DI void att_tile(const unsigned char* Ks, const bf16x8 (&qr)[8], f32x16 (&o)[8], float base, float slope2, float negM, float& l_reg, int r32, int hi, int vb0, int vb1) {
  f32x16 p0, p1;
#pragma unroll
  for (int i = 0; i < 16; ++i) { p0[i] = negM; p1[i] = negM; }
#pragma unroll
  for (int d0 = 0; d0 < 8; ++d0) { const int cb = (d0 * 16 + hi * 8) * 2;
    const bf16x8 b0 = *(const bf16x8*)(Ks + KSWZ(r32, cb)); const bf16x8 b1 = *(const bf16x8*)(Ks + KSWZ(32 + r32, cb));
    p0 = MFMA32(b0, qr[d0], p0); p1 = MFMA32(b1, qr[d0], p1); if ((d0 & 1) == 1) SBAR(); }
  bf16x8 pa0, pa1;
  sm_half(p0, base, slope2, l_reg, pa0, pa1);
  pv_pipe<0>(o, vb0, vb1, pa0, pa1);
  sm_half(p1, base - 32.f, slope2, l_reg, pa0, pa1);
  pv_pipe<1>(o, vb0, vb1, pa0, pa1);
}

DI void attn_phase(const Params& p, unsigned char* smem, int jc, float lambda_init, unsigned* ctr, int wv) {
  const int tid = tid_of(wv), wid = __builtin_amdgcn_readfirstlane(tid >> 6), lane = tid & 63, r32 = lane & 31, hi = lane >> 5;
  const int rg = wid & 3, mp = wid >> 2;
  const bf16_t* X = (const bf16_t*)(p.ws + WS_ACT); bf16_t* Y = (bf16_t*)(p.ws + WS_Y);
  LAS unsigned char* lds = (LAS unsigned char*)smem;
  float* wsc = (float*)(smem + 131072 + wid * 256); float* li_l = wsc; float* al_l = wsc + 32;
  float lam_full;
  { const float* lf = p.c_lam + (size_t)jc * 512; float s1 = 0.f, s2 = 0.f;
    for (int i = 0; i < 128; ++i) { s1 += lf[i] * lf[128 + i]; s2 += lf[256 + i] * lf[384 + i]; }
    lam_full = __expf(s1) - __expf(s2) + lambda_init; }
  const unsigned ldsw = (unsigned)wid * 1024u;
  unsigned char* ofs_l = smem + 135168 + wid * 1024;
  { u32x4 ofs;
    unsigned kofs[2], vofs[2];
#pragma unroll
    for (int _i = 0; _i < 2; ++_i) { const int Bo = _i * 8192 + wid * 1024 + lane * 16;
      { const int row = Bo >> 8, chp = (Bo >> 4) & 15, chn = chp ^ (row & 7); kofs[_i] = (unsigned)(row * NC + chn * 8); }
      { const int st = Bo >> 9, e = (Bo & 511) >> 1, kk = (st >> 2) * 8 + (e >> 5), c = (st & 3) * 32 + (e & 31); const int k = (kk & ~0xC) | ((kk & 4) << 1) | ((kk & 8) >> 1); vofs[_i] = (unsigned)(k * NC + c); } }
    ofs.x = kofs[0]; ofs.y = kofs[1]; ofs.z = vofs[0]; ofs.w = vofs[1];
    *(u32x4*)(ofs_l + lane * 16) = ofs; }
#define ATT_LOAD(buf, key0) do { const bf16_t* kb_ = X + (size_t)(key0) * NC + 2048 + head * 256; const bf16_t* vb_ = X + (size_t)(key0) * NC + 4096 + head * 256; \
    const u32x4 ofs_ = *(const u32x4*)(ofs_l + opq(lane) * 16); const unsigned kofs[2] = {ofs_.x, ofs_.y}, vofs[2] = {ofs_.z, ofs_.w}; \
    _Pragma("unroll") for (int _i = 0; _i < 2; ++_i) { \
      __builtin_amdgcn_global_load_lds((const unsigned*)(kb_ + kofs[_i]), (LAS unsigned*)(lds + (buf) * 65536 + ldsw + _i * 8192), 16, 0, 0); \
      __builtin_amdgcn_global_load_lds((const unsigned*)(kb_ + 128 + kofs[_i]), (LAS unsigned*)(lds + (buf) * 65536 + 16384 + ldsw + _i * 8192), 16, 0, 0); \
      __builtin_amdgcn_global_load_lds((const unsigned*)(vb_ + vofs[_i]), (LAS unsigned*)(lds + (buf) * 65536 + 32768 + ldsw + _i * 8192), 16, 0, 0); \
      __builtin_amdgcn_global_load_lds((const unsigned*)(vb_ + 128 + vofs[_i]), (LAS unsigned*)(lds + (buf) * 65536 + 49152 + ldsw + _i * 8192), 16, 0, 0); } } while (0)
  const int vbl = (int)(unsigned)(size_t)lds + v_rd_base(lane);
  const unsigned* nm = (const unsigned*)(p.ws + WS_CTR) + 16;
  const float bound2 = 2.f * 1.01f * sqrtf(__uint_as_float(nm[0]) * __uint_as_float(nm[1])) + 38.f;
  int* item_l = (int*)(smem + 131072 + 2048);
  float* cst_l = (float*)(smem + 131072 + 2048 + 128);
  cst_l[0] = lam_full; cst_l[1] = bound2;
  bool first = true;
  for (;;) {
    __syncthreads();
    if (tid == 0) *item_l = first ? (int)blockIdx.x : (int)(gridDim.x + atomicAdd(ctr, 1u));
    first = false;
    __syncthreads();
    const int item = *item_l;
    if (item >= 1024) break;
    const int head = 7 - (item >> 7), qb = (item & 7) * 16 + ((item >> 3) & 15), q0 = qb * 128;
    const float slope2 = exp2f(-(float)(head + 1)) * 1.4426950408889634f;
    const int qrow = q0 + rg * 32 + r32;
    const float bound2i = cst_l[1];
    const int Wd = (int)ceilf(bound2i / slope2);
    int jt_lo = q0 - Wd - 63; jt_lo = jt_lo < 0 ? 0 : (jt_lo >> 6) + 1;
    int jt_hi = (q0 + 127 + Wd + 63) >> 6; jt_hi = (jt_hi > SEQ / 64 ? SEQ / 64 : jt_hi);
    const int jc0 = q0 >> 6;
    const float L2m = 0.5f * (bound2i - 38.f);
    float* mm_l = (float*)(smem + 131072 + 2048 + 64);
    int dlim = 0x7fffffff;
    auto next_tile = [&](int cur) -> int {
      int cand;
      if (cur == jc0) return jc0 + 1;
      if (cur <= jc0 + 1) { cand = (cur == jc0 + 1) ? jc0 - 1 : cur - 1;
        if (cand >= jt_lo && (q0 - (64 * cand + 63)) < dlim) return cand;
        cand = jc0 + 2; }
      else cand = cur + 1;
      if (cand < jt_hi && (64 * cand - (q0 + 127)) < dlim) return cand;
      return -1; };
    int cur = jc0;
    ATT_LOAD(0, cur * 64);
    bf16x8 qr[8];
    { const int lq = opq(lane); const bf16_t* qp = X + (size_t)(q0 + rg * 32 + (lq & 31)) * NC + head * 256 + mp * 128 + (lq >> 5) * 8;
#pragma unroll
      for (int d0 = 0; d0 < 8; ++d0) qr[d0] = *(const bf16x8*)(qp + d0 * 16); }
    f32x16 o[8];
#pragma unroll
    for (int d = 0; d < 8; ++d) o[d] = (f32x16){};
    float l_reg = 0.f; const float negM = -L2m;
    asm volatile("s_waitcnt vmcnt(0)" ::: "memory");
    __syncthreads();
    for (int it = 0;; ++it) {
      const int buf = it & 1;
      const int nxt = next_tile(cur);
      if (nxt >= 0) ATT_LOAD(buf ^ 1, nxt * 64);
      const unsigned char* Ks = smem + buf * 65536 + mp * 16384;
      const int vb0 = vbl + buf * 65536 + 32768, vb1 = vb0 + 16384;
      const float base = (float)(qrow - 64 * cur - 4 * hi);
      att_tile(Ks, qr, o, base, slope2, negM, l_reg, r32, hi, vb0, vb1);
      if ((it & 3) == 0) { float mw = l_reg; mw = fminf(mw, __shfl_xor(mw, 1)); mw = fminf(mw, __shfl_xor(mw, 2)); mw = fminf(mw, __shfl_xor(mw, 4)); mw = fminf(mw, __shfl_xor(mw, 8)); mw = fminf(mw, __shfl_xor(mw, 16));
        if (lane == 0) mm_l[buf * 8 + wid] = mw; }
      asm volatile("s_waitcnt vmcnt(0)" ::: "memory");
      __syncthreads();
      if (nxt < 0) break;
      if ((it & 3) == 0) { const f32x4 a = *(const f32x4*)(mm_l + buf * 8), b = *(const f32x4*)(mm_l + buf * 8 + 4);
        const float mmin = fminf(fminf(fminf(a[0], a[1]), fminf(a[2], a[3])), fminf(fminf(b[0], b[1]), fminf(b[2], b[3])));
        dlim = __builtin_amdgcn_readfirstlane((int)fminf(ceilf((39.f - __builtin_amdgcn_logf(mmin)) / slope2), 1.0e9f)); }
      cur = nxt;
    }
    const int lee = opq(lane), r32e = lee & 31, hie = lee >> 5;
    if (hie == 0) li_l[r32e] = l_reg; LGKM0();
    {
#pragma unroll
      for (int r = 0; r < 16; ++r) { const float rl = (mp == 1 ? cst_l[0] : 1.f) * __builtin_amdgcn_rcpf(li_l[crow(r, hie)]);
#pragma unroll
        for (int d = 0; d < 8; ++d) o[d][r] *= rl; }
    }
    SBAR();
    float* xch = (float*)smem + (size_t)rg * 8192;
    if (mp == 1) {
#pragma unroll
      for (int d = 0; d < 8; ++d) {
#pragma unroll
        for (int r = 0; r < 16; ++r) xch[(d * 16 + r) * 64 + lane] = o[d][r];
        SBAR(); }
    }
    __syncthreads();
    if (mp == 0) {
      float ss[16];
#pragma unroll
      for (int r = 0; r < 16; ++r) ss[r] = 0.f;
#pragma unroll
      for (int d = 0; d < 8; ++d) {
#pragma unroll
        for (int r = 0; r < 16; ++r) { const float v = o[d][r] - xch[(d * 16 + r) * 64 + lane]; o[d][r] = v; ss[r] = fmaf(v, v, ss[r]); }
        SBAR(); }
#pragma unroll
      for (int r = 0; r < 16; ++r) { float s = ss[r]; s += __shfl_xor(s, 1); s += __shfl_xor(s, 2); s += __shfl_xor(s, 4); s += __shfl_xor(s, 8); s += __shfl_xor(s, 16);
        ss[r] = rsqrtf(s * (1.f / 256.f) + EPS) * (1.f - lambda_init); }
#pragma unroll
      for (int d = 0; d < 8; ++d) { const float ogv = p.c_o_g[(size_t)jc * 256 + d * 32 + r32e];
#pragma unroll
        for (int r = 0; r < 16; ++r) xch[crow(r, hie) * 256 + d * 32 + r32e] = o[d][r] * ss[r] * ogv;
        SBAR(); }
      LGKM0();
      const int le = opq(lane);
      for (int rb = 0; rb < 32; rb += 8) {
        f32x4 v[8]; u32x2 zz[8];
#pragma unroll
        for (int k = 0; k < 8; ++k) { const int row = q0 + rg * 32 + rb + k;
          v[k] = *(const f32x4*)(xch + (rb + k) * 256 + le * 4);
          zz[k] = *(const u32x2*)(X + (size_t)row * NC + 6144 + head * 256 + le * 4); }
#pragma unroll
        for (int k = 0; k < 8; ++k) { const int row = q0 + rg * 32 + rb + k;
          u32x2 w = {cvt2(v[k][0] * silu(bflo(zz[k].x)), v[k][1] * silu(bfhi(zz[k].x))), cvt2(v[k][2] * silu(bflo(zz[k].y)), v[k][3] * silu(bfhi(zz[k].y)))};
          *(u32x2*)(Y + (size_t)row * DIN + head * 256 + le * 4) = w; } }
    }
  }
  __syncthreads();
#undef ATT_LOAD
}

#define XB_TMO      128
#define XB_XCNT(j)  (256  + 64 * (j))
#define XB_XSUB(j)  (1280 + 64 * (j))
#define XB_XGEN(j)  (2304 + 64 * (j))
#define XB_TOP      3328
#define XB_TOPGEN   3392
#define XCD_BAR_WORDS 3456
#define XB_SPIN_CAP (1u << 18)
DI unsigned xb_ld(unsigned* p)              { return __hip_atomic_load(p, __ATOMIC_RELAXED, __HIP_MEMORY_SCOPE_AGENT); }
DI unsigned xb_add(unsigned* p, unsigned v) { return __hip_atomic_fetch_add(p, v, __ATOMIC_RELAXED, __HIP_MEMORY_SCOPE_AGENT); }
DI unsigned xb_xcc_id() { return (unsigned)__builtin_amdgcn_s_getreg((3 << 11) | 20) & 0xFu; }
#define XB_SPIN(cond, bar) do { unsigned _sp = 0; while (cond) { __builtin_amdgcn_s_sleep(1); \
    if ((++_sp & 255u) == 0u) { if (xb_ld(&(bar)[XB_TMO])) break; if (_sp > XB_SPIN_CAP) { atomicAdd(&(bar)[XB_TMO], 1u); break; } } } } while (0)
struct XcdBarrier { unsigned* bar; unsigned x; volatile LAS unsigned* st; };
DI void xcd_barrier_complete(unsigned* bar, unsigned x, unsigned& nloc, unsigned& nx) {
  const unsigned G = gridDim.x * gridDim.y * gridDim.z;
  unsigned sum, cnt, mine, sp = 0u;
  for (;;) {
    sum = 0u; cnt = 0u; mine = 0u;
#pragma unroll
    for (unsigned j = 0; j < 16; ++j) { const unsigned c = xb_ld(&bar[XB_XCNT(j)]); sum += c; cnt += (c > 0u) ? 1u : 0u; mine = (j == x) ? c : mine; }
    if (sum == G) break;
    __builtin_amdgcn_s_sleep(1);
    if ((++sp & 255u) == 0u) { if (xb_ld(&bar[XB_TMO])) break; if (sp > XB_SPIN_CAP) { atomicAdd(&bar[XB_TMO], 1u); break; } }
  }
  nloc = mine > 0u ? mine : 1u; nx = cnt > 0u ? cnt : 1u;
}
DI void gsync(const XcdBarrier& b, int wv) {
  asm volatile("s_waitcnt vmcnt(0) lgkmcnt(0)" ::: "memory");
  __syncthreads();
  if (tid_of(wv) == 0) {
    unsigned* bar = b.bar;
    __builtin_amdgcn_s_waitcnt(0);
    unsigned nloc = b.st[0], nx = b.st[1];
    if (nloc == 0u) { xcd_barrier_complete(bar, b.x, nloc, nx); b.st[0] = nloc; b.st[1] = nx; }
    const unsigned old = xb_add(&bar[XB_XSUB(b.x)], 1u);
    const unsigned gen = old / nloc;
    if (old + 1u == (gen + 1u) * nloc) {
      __builtin_amdgcn_fence(__ATOMIC_RELEASE, "agent");
      asm volatile("s_waitcnt vmcnt(0)" ::: "memory");
      const unsigned og = xb_add(&bar[XB_TOP], 1u);
      const unsigned tg = og / nx;
      if (og + 1u == (tg + 1u) * nx) xb_add(&bar[XB_TOPGEN], 1u);
      else XB_SPIN(xb_ld(&bar[XB_TOPGEN]) == tg, bar);
      __builtin_amdgcn_fence(__ATOMIC_ACQUIRE, "agent");
      xb_add(&bar[XB_XGEN(b.x)], 1u);
      asm volatile("s_waitcnt vmcnt(0)" ::: "memory");
    } else {
      XB_SPIN(xb_ld(&bar[XB_XGEN(b.x)]) == gen, bar);
      __builtin_amdgcn_fence(__ATOMIC_ACQUIRE, "agent");
      asm volatile("s_waitcnt vmcnt(0)" ::: "memory");
    }
  }
  __syncthreads();
}

__global__ void __launch_bounds__(512) mega(Params p) {
  extern __shared__ __attribute__((aligned(16))) unsigned char smem[];
  cg::grid_group grid = cg::this_grid();
  const int wv = __builtin_amdgcn_readfirstlane((int)(threadIdx.x >> 6));
  XcdBarrier xb; xb.bar = (unsigned*)(p.ws + WS_BAR); xb.x = xb_xcc_id(); xb.st = (volatile LAS unsigned*)((LAS unsigned char*)smem + (LDS_BYTES - 16));
  if (threadIdx.x == 0) { xb.st[0] = 0u; xb.st[1] = 0u; (void)xb_add(&xb.bar[XB_XCNT(xb.x)], 1u); }
  __syncthreads();
  bf16_t* Wb = (bf16_t*)(p.ws + WS_W); bf16_t* Wo = (bf16_t*)(p.ws + WS_WOUT);
  bf16_t* XB = (bf16_t*)(p.ws + WS_XB); bf16_t* ACT = (bf16_t*)(p.ws + WS_ACT); bf16_t* Yb = (bf16_t*)(p.ws + WS_Y);
  float* vss = (float*)(p.ws + WS_VSS);
  for (int layer = 0; layer < 4; ++layer) {
    const int kind = layer % 3, j = layer / 3;
    if (layer == 0) norm_rows(p, layer, wv); else rstd_rows(p, wv);
    const float* ng = p.norm_g + (size_t)layer * DM;
    if (kind == 0) {
      conv_weight_T(smem, p.a_w_in + (size_t)j * DM * NA, DM, NA, NA, Wb, ng, 0, 1.f, wv);
      conv_weight_T(smem, p.a_w_out + (size_t)j * DIN * DM, DIN, DM, DM, Wo, nullptr, 0, 1.f, wv);
    } else if (kind == 1) {
      conv_weight_T(smem, p.b_w_in + (size_t)j * DM * 5152, DM, 5152, NB, Wb, ng, 512, 0.08838834764831845f, wv);
      conv_weight_T(smem, p.b_w_out + (size_t)j * DIN * DM, DIN, DM, DM, Wo, nullptr, 0, 1.f, wv);
    } else {
      conv_weight_T(smem, p.c_w_in + (size_t)j * DM * NC, DM, NC, NC, Wb, ng, 0, 1.f, wv);
      conv_weight_T(smem, p.c_w_out + (size_t)j * DIN * DM, DIN, DM, DM, Wo, nullptr, 0, 1.f, wv);
      { const int t8 = tid_of(wv); if (blockIdx.x == 0 && t8 < 32) ((unsigned*)(p.ws + WS_CTR))[t8] = 0u; }
    }
    if (layer == 0) { asm volatile("s_waitcnt vmcnt(0) lgkmcnt(0)" ::: "memory"); grid.sync(); } else gsync(xb, wv);
    for (int step = 0; step <= NSEQ; ++step) {
      if (step > 0) { const int sq = step - 1; float* xo = p.out + (size_t)sq * SEQ * DM;
        const float* xi = (layer == 0) ? (sq < 2 ? p.x_prompt + (size_t)sq * SEQ * DM : p.x_sample) : xo;
        run_gemm(smem, Yb, Wo, SEQ, DM, DIN, pg8::EpiRes{xo, xi, DM, layer < 3 ? XB + (size_t)sq * SEQ * DM : nullptr, (float*)(p.ws + WS_XSSP) + (size_t)sq * SEQ * 16}, wv); }
      if (step < NSEQ) { const bf16_t* xa = XB + (size_t)step * SEQ * DM; const float* rstd = (const float*)(p.ws + WS_RSTD) + (size_t)step * SEQ;
        if (kind == 0) run_gemm(smem, xa, Wb, SEQ, NA, DM, pg8::EpiBf16<true>{ACT, NA, vss, rstd}, wv);
        else if (kind == 1) run_gemm(smem, xa, Wb, SEQ, NB, DM, pg8::EpiBf16<false>{ACT, NB, nullptr, rstd}, wv);
        else run_gemm(smem, xa, Wb, SEQ, NC, DM, pg8::EpiBf16<false>{ACT, NC, nullptr, rstd}, wv); }
      gsync(xb, wv);
      if (step == NSEQ) break;
      const int seq = step;
      if (kind == 0) {
        sgu_phase(p, smem, seq, j, wv); gsync(xb, wv);
      } else if (kind == 1) {
        gla_prep_phase(p, smem, j, wv); gsync(xb, wv);
        gla_chain_phase(p, smem, wv); gsync(xb, wv);
        gla_post_phase(p, j, wv); gsync(xb, wv);
      } else {
        qknorm_phase(p, smem, j, wv); gsync(xb, wv);
        attn_phase(p, smem, j, 0.8f - 0.6f * 0.5488116360940264f, (unsigned*)(p.ws + WS_CTR) + seq, wv); gsync(xb, wv);
      }
    }
  }
}

extern "C" void kernel_launch(void* const* d_in, const int* in_sizes, int n_in, void* d_out, int out_size, void* d_ws, size_t ws_size, hipStream_t stream) {
  static int grid = 0;
  if (grid == 0) {
    if (n_in != 19 || ws_size < WS_END) { fprintf(stderr, "kernel_launch: unexpected n_in %d or ws_size %zu (< %zu)\n", n_in, ws_size, (size_t)WS_END); grid = -1; return; }
    int dev = 0, cus = 0, per_cu = 0;
    hipGetDevice(&dev); hipDeviceGetAttribute(&cus, hipDeviceAttributeMultiprocessorCount, dev);
    if (hipFuncSetAttribute((const void*)mega, hipFuncAttributeMaxDynamicSharedMemorySize, LDS_BYTES) != hipSuccess) { fprintf(stderr, "kernel_launch: hipFuncSetAttribute failed\n"); grid = -1; return; }
    if (hipOccupancyMaxActiveBlocksPerMultiprocessor(&per_cu, (const void*)mega, 512, LDS_BYTES) != hipSuccess || per_cu < 1) { fprintf(stderr, "kernel_launch: occupancy query gave %d\n", per_cu); per_cu = 1; }
    (void)hipGetLastError();
    grid = cus * 1;
  }
  if (grid < 0) return;
  Params p{};
  p.x_prompt = (const float*)d_in[0]; p.x_sample = (const float*)d_in[1]; p.norm_g = (const float*)d_in[2];
  p.a_w_in = (const float*)d_in[3]; p.a_v_g = (const float*)d_in[4]; p.a_w_s = (const float*)d_in[5]; p.a_b_s = (const float*)d_in[6]; p.a_w_out = (const float*)d_in[7];
  p.b_w_in = (const float*)d_in[8]; p.b_w_gate = (const float*)d_in[9]; p.b_gate_bias = (const float*)d_in[10]; p.b_o_g = (const float*)d_in[11]; p.b_w_out = (const float*)d_in[12];
  p.c_w_in = (const float*)d_in[13]; p.c_q_g = (const float*)d_in[14]; p.c_k_g = (const float*)d_in[15]; p.c_lam = (const float*)d_in[16]; p.c_o_g = (const float*)d_in[17]; p.c_w_out = (const float*)d_in[18];
  p.out = (float*)d_out; p.ws = (unsigned char*)d_ws;
  (void)hipMemsetAsync((unsigned char*)d_ws + WS_BAR, 0, XCD_BAR_WORDS * sizeof(unsigned), stream);
  void* args[] = {&p};
  hipError_t e = hipLaunchCooperativeKernel((const void*)mega, dim3(grid), dim3(512), args, LDS_BYTES, stream);
  if (e != hipSuccess) fprintf(stderr, "cooperative launch failed: %s (grid %d)\n", hipGetErrorString(e), grid);
}
```

```cpp
#include <hip/hip_runtime.h>
#include <hip/hip_cooperative_groups.h>
#include <cstdio>
namespace cg = cooperative_groups;

#define DI __device__ __forceinline__
#define LAS __attribute__((address_space(3)))
typedef unsigned short bf16_t;
typedef short bf16x8 __attribute__((ext_vector_type(8)));
typedef short s16x4 __attribute__((ext_vector_type(4)));
typedef float f32x2 __attribute__((ext_vector_type(2)));
typedef float f32x4 __attribute__((ext_vector_type(4)));
typedef float f32x16 __attribute__((ext_vector_type(16)));
typedef unsigned u32x4 __attribute__((ext_vector_type(4)));
typedef unsigned u32x2 __attribute__((ext_vector_type(2)));
typedef __bf16 bf16x2_t __attribute__((ext_vector_type(2)));

constexpr int SEQ = 16384, DM = 1024, DIN = 2048, NSEQ = 3, NTOK = NSEQ * SEQ;
constexpr float EPS = 1e-6f;
constexpr size_t MiB = 1u << 20;
constexpr size_t WS_W = 0, WS_WOUT = 16 * MiB, WS_XB = 20 * MiB, WS_ACT = 116 * MiB, WS_Y = 412 * MiB, WS_MISC = 476 * MiB;
constexpr size_t WS_GLAE = WS_MISC, WS_VSS = WS_MISC + 4 * MiB, WS_CTR = WS_VSS + 2 * MiB, WS_RSTD = WS_CTR + 1 * MiB, WS_XSSP = WS_RSTD + 1 * MiB, WS_BAR = WS_XSSP + 3 * MiB, WS_END = WS_BAR + 65536;
constexpr int LDS_BYTES = 144 * 1024;
constexpr int NA = 6144, NB = 5376, NC = 8192;

struct Params {
  const float* x_prompt; const float* x_sample; const float* norm_g;
  const float* a_w_in; const float* a_v_g; const float* a_w_s; const float* a_b_s; const float* a_w_out;
  const float* b_w_in; const float* b_w_gate; const float* b_gate_bias; const float* b_o_g; const float* b_w_out;
  const float* c_w_in; const float* c_q_g; const float* c_k_g; const float* c_lam; const float* c_o_g; const float* c_w_out;
  float* out; unsigned char* ws;
};

DI unsigned cvt2(float a, float b) { f32x2 v = {a, b}; bf16x2_t r = __builtin_convertvector(v, bf16x2_t); return __builtin_bit_cast(unsigned, r); }
DI float bf2f(bf16_t v) { return __uint_as_float(((unsigned)v) << 16); }
DI float bflo(unsigned w) { return __uint_as_float(w << 16); }
DI float bfhi(unsigned w) { return __uint_as_float(w & 0xffff0000u); }
DI bf16_t f2bf(float a) { return (bf16_t)(cvt2(a, 0.f) & 0xffffu); }
DI int opq(int x) { asm volatile("" : "+v"(x)); return x; }
DI int tid_of(int wv) { int l; asm volatile("v_mbcnt_lo_u32_b32 %0, -1, 0\n\tv_mbcnt_hi_u32_b32 %0, -1, %0" : "=v"(l)); return (wv << 6) | l; }
DI int crow(int r, int hi) { return (r & 3) + 8 * (r >> 2) + 4 * hi; }
DI float wave_sum(float v) { for (int o = 32; o >= 1; o >>= 1) v += __shfl_xor(v, o); return v; }
DI float silu(float z) { return z * __builtin_amdgcn_rcpf(1.f + __expf(-z)); }
#define MFMA32(a, b, c) __builtin_amdgcn_mfma_f32_32x32x16_bf16((a), (b), (c), 0, 0, 0)
template <int OFF> DI s16x4 tr_read(unsigned addr) { s16x4 r; asm volatile("ds_read_b64_tr_b16 %0, %1 offset:%2" : "=&v"(r) : "v"(addr), "i"(OFF) : "memory"); return r; }
DI s16x4 tr_read0(unsigned addr) { s16x4 r; asm volatile("ds_read_b64_tr_b16 %0, %1" : "=&v"(r) : "v"(addr) : "memory"); return r; }
#define LGKM0() asm volatile("s_waitcnt lgkmcnt(0)" ::: "memory")
#define SBAR() __builtin_amdgcn_sched_barrier(0)
#define PK8(L, H) (bf16x8){L[0], L[1], L[2], L[3], H[0], H[1], H[2], H[3]}
DI bf16x8 pack8(float a0, float a1, float a2, float a3, float a4, float a5, float a6, float a7) {
  u32x4 w = {cvt2(a0, a1), cvt2(a2, a3), cvt2(a4, a5), cvt2(a6, a7)}; return __builtin_bit_cast(bf16x8, w);
}

namespace pg8 {
constexpr int BM = 256, BK = 64, HALF = 128, HTB = HALF * BK * 2, STAGE_BYTES = 8 * HTB, NXCD = 8, WGM = 8;
DI int lds_byte(int r, int c) { const int st = (r >> 4) * 2 + (c >> 5), rr = r & 15, cc = c & 31, ob = rr * 64 + cc * 2; return st * 1024 + (ob ^ (((ob >> 9) & 1) << 5)); }
DI void stage_rc(int b, int& R, int& C) { const int st = b / 1024, sb = b % 1024, swz = sb ^ (((sb >> 9) & 1) << 5); R = (st >> 1) * 16 + swz / 64; C = (st & 1) * 32 + (swz % 64) / 2; }
DI int perm32(int rho) { const int n = rho >> 4, i = rho & 15; return 8 * (i >> 2) + 4 * n + (i & 3); }
struct Unit { int pm, pn; };
struct Gemm { const bf16_t* A; const bf16_t* Bt; int M, N, K; };
struct StaticOrder {
  int nM, nN, nwg, G, c;
  DI void init(int M, int N, int G_, int c_) { nM = M / BM; nN = N / BM; nwg = nM * nN; G = G_; c = c_; }
  DI bool next(int i, Unit& u) const {
    const long L = (long)i * G + c; if (L >= nwg) return false;
    int wgid = (int)L; { const int q = nwg / NXCD, r = nwg % NXCD, xcd = wgid % NXCD, off = wgid / NXCD; wgid = (xcd < r ? xcd * (q + 1) : r * (q + 1) + (xcd - r) * q) + off; }
    const int nig = WGM * nN, gid = wgid / nig, fm = gid * WGM, gsz = (nM - fm) < WGM ? (nM - fm) : WGM;
    u.pm = fm + ((wgid % nig) % gsz); u.pn = (wgid % nig) / gsz; return true;
  }
};
template <bool VSS> struct EpiBf16 {
  static constexpr bool PERM = true;
  bf16_t* O; int ldc; float* vss; const float* rstd;
  DI void operator()(const f32x4 (&acc)[2][2][4][2], const Unit& u, int wr, int wc, int fr, int fq) const {
    const int row0 = u.pm * BM + wr * 64 + fr; const int col0 = u.pn * BM + wc * 32 + 8 * fq;
    const bool dov = VSS && (u.pn >= 8) && (u.pn < 16);
#pragma unroll
    for (int ai = 0; ai < 2; ++ai)
#pragma unroll
      for (int m = 0; m < 4; ++m) {
        bf16_t* rowp = O + (size_t)(row0 + ai * HALF + m * 16) * ldc + col0; float ss = 0.f; const float rs = rstd[row0 + ai * HALF + m * 16];
#pragma unroll
        for (int bj = 0; bj < 2; ++bj) { const f32x4 v0 = acc[ai][bj][m][0] * rs, v1 = acc[ai][bj][m][1] * rs;
          u32x4 w; w.x = cvt2(v0[0], v0[1]); w.y = cvt2(v0[2], v0[3]); w.z = cvt2(v1[0], v1[1]); w.w = cvt2(v1[2], v1[3]);
          *(u32x4*)(rowp + bj * HALF) = w;
          if (VSS) { ss += v0[0] * v0[0] + v0[1] * v0[1] + v0[2] * v0[2] + v0[3] * v0[3] + v1[0] * v1[0] + v1[1] * v1[1] + v1[2] * v1[2] + v1[3] * v1[3]; } }
        if (VSS) { if (dov) { ss += __shfl_xor(ss, 16); ss += __shfl_xor(ss, 32); if (fq == 0) vss[(size_t)(row0 + ai * HALF + m * 16) * 32 + (u.pn - 8) * 4 + wc] = ss; } }
      }
  }
};
struct EpiRes {
  static constexpr bool PERM = false;
  float* out; const float* xin; int ldc; bf16_t* xb; float* xssp;
  DI void operator()(const f32x4 (&acc)[2][2][4][2], const Unit& u, int wr, int wc, int fr, int fq) const {
    const int row0 = u.pm * BM + wr * 64 + fr, col0 = u.pn * BM + wc * 32 + 4 * fq;
#pragma unroll
    for (int ai = 0; ai < 2; ++ai)
#pragma unroll
      for (int m = 0; m < 4; ++m) { const size_t ro = (size_t)(row0 + ai * HALF + m * 16) * ldc + col0; float ss = 0.f;
#pragma unroll
        for (int bj = 0; bj < 2; ++bj)
#pragma unroll
          for (int n = 0; n < 2; ++n) { const f32x4 xv = *(const f32x4*)(xin + ro + bj * HALF + n * 16); const f32x4 v = acc[ai][bj][m][n] + xv; *(f32x4*)(out + ro + bj * HALF + n * 16) = v;
            if (xb) { *(u32x2*)(xb + ro + bj * HALF + n * 16) = (u32x2){cvt2(v[0], v[1]), cvt2(v[2], v[3])}; ss += v[0] * v[0] + v[1] * v[1] + v[2] * v[2] + v[3] * v[3]; } }
        if (xb) { ss += __shfl_xor(ss, 16); ss += __shfl_xor(ss, 32); if (fq == 0) xssp[(size_t)(row0 + ai * HALF + m * 16) * 16 + u.pn * 4 + wc] = ss; } }
  }
};

template <class Epi>
DI void gemm_phase(LAS unsigned char* lds, const Gemm g, const StaticOrder& S, const Epi& E, int wv) {
  const int tid = tid_of(wv), wid = __builtin_amdgcn_readfirstlane(tid >> 6), lane = tid & 63, wr = wid >> 2, wc = wid & 3, fr = lane & 15, fq = lane >> 4;
  const int K = g.K, nt = K / BK;
  unsigned voffA[2], voffB[2];
#pragma unroll
  for (int i = 0; i < 2; ++i) { int R, C; stage_rc(tid * 16 + i * 8192, R, C); const int Rb = Epi::PERM ? ((R & ~31) + perm32(R & 31)) : R;
    voffA[i] = (unsigned)(R * K + C) * 2u; voffB[i] = (unsigned)(Rb * K + C) * 2u; }
  const size_t kstep = (size_t)(BK * 2);
  const size_t hstep = (size_t)HALF * K * 2;
  const size_t tstep = 2 * hstep;
  const unsigned ldsw = (unsigned)wid * 1024u;
  const int aoff = lds_byte(wr * 64 + fr, fq * 8), boff = lds_byte(wc * 32 + fr, fq * 8);
#define PG8_SA(b, h) (((b) * 2 + (h)) * HTB)
#define PG8_SB(b, h) ((4 + (b) * 2 + (h)) * HTB)
#define PG8_STAGE(bufoff, gbase, voff) do { _Pragma("unroll") for (int _i = 0; _i < 2; ++_i) \
    __builtin_amdgcn_global_load_lds((const unsigned*)((const char*)(gbase) + (voff)[_i]), (LAS unsigned*)(lds + (bufoff) + ldsw + _i * 8192), 16, 0, 0); } while (0)
#define PG8_LDA(dst, b, h) do { _Pragma("unroll") for (int m = 0; m < 4; ++m) _Pragma("unroll") for (int k = 0; k < 2; ++k) dst[m][k] = *(const LAS bf16x8*)(lds + PG8_SA(b, h) + aoff + m * 2048 + k * 1024); } while (0)
#define PG8_LDB(dst, b, h) do { _Pragma("unroll") for (int n = 0; n < 2; ++n) _Pragma("unroll") for (int k = 0; k < 2; ++k) dst[n][k] = *(const LAS bf16x8*)(lds + PG8_SB(b, h) + boff + n * 2048 + k * 1024); } while (0)
#define PG8_MMA(ai, bj, At, Bt) do { __builtin_amdgcn_s_setprio(1); _Pragma("unroll") for (int m = 0; m < 4; ++m) _Pragma("unroll") for (int n = 0; n < 2; ++n) _Pragma("unroll") for (int k = 0; k < 2; ++k) \
    acc[ai][bj][m][n] = __builtin_amdgcn_mfma_f32_16x16x32_bf16(Bt[n][k], At[m][k], acc[ai][bj][m][n], 0, 0, 0); __builtin_amdgcn_s_setprio(0); } while (0)
#define PG8_WAIT_V(n) asm volatile("s_waitcnt vmcnt(" #n ")" ::: "memory")
#define PG8_WAIT_L(n) asm volatile("s_waitcnt lgkmcnt(" #n ")" ::: "memory")
#define PG8_BAR __builtin_amdgcn_s_barrier()
#define PG8_SCHED __builtin_amdgcn_sched_barrier(0)
  Unit cur, nxt; int ui = 0;
  if (!S.next(0, cur)) return;
  f32x4 acc[2][2][4][2];
#pragma unroll
  for (int a = 0; a < 2; ++a)
#pragma unroll
    for (int b = 0; b < 2; ++b)
#pragma unroll
      for (int m = 0; m < 4; ++m)
#pragma unroll
        for (int n = 0; n < 2; ++n) acc[a][b][m][n] = (f32x4){0.f, 0.f, 0.f, 0.f};
  bf16x8 At[4][2], B0[2][2], B1[2][2];
  const char* cA = (const char*)g.A + (size_t)cur.pm * tstep; const char* cB = (const char*)g.Bt + (size_t)cur.pn * tstep;
  PG8_STAGE(PG8_SB(0, 0), cB, voffB); PG8_STAGE(PG8_SA(0, 0), cA, voffA); PG8_STAGE(PG8_SB(0, 1), cB + hstep, voffB); PG8_STAGE(PG8_SA(0, 1), cA + hstep, voffA);
  if (wr == 1) PG8_BAR;
  PG8_WAIT_V(4); PG8_BAR;
  PG8_STAGE(PG8_SB(1, 0), cB + kstep, voffB); PG8_STAGE(PG8_SA(1, 0), cA + kstep, voffA); PG8_STAGE(PG8_SB(1, 1), cB + hstep + kstep, voffB);
  PG8_WAIT_V(6); PG8_BAR;
  for (;;) {
    const bool has_next = S.next(ui + 1, nxt);
    const char* nA = has_next ? (const char*)g.A + (size_t)nxt.pm * tstep : cA; const char* nB = has_next ? (const char*)g.Bt + (size_t)nxt.pn * tstep : cB;
    for (int t = 0; t < nt; t += 2) {
      const bool last = (t == nt - 2);
      const char* a1 = cA + (size_t)(t + 1) * kstep;
      const char* a2 = last ? nA : cA + (size_t)(t + 2) * kstep; const char* b2 = last ? nB : cB + (size_t)(t + 2) * kstep;
      const char* a3 = a2 + kstep; const char* b3 = b2 + kstep;
      PG8_LDB(B0, 0, 0); PG8_SCHED; PG8_LDA(At, 0, 0); PG8_STAGE(PG8_SA(1, 1), a1 + hstep, voffA);
      PG8_WAIT_L(8); PG8_BAR; PG8_WAIT_L(0); PG8_MMA(0, 0, At, B0); PG8_BAR; PG8_SCHED;
      PG8_LDB(B1, 0, 1); PG8_STAGE(PG8_SB(0, 0), b2, voffB);
      PG8_BAR; PG8_WAIT_L(0); PG8_MMA(0, 1, At, B1); PG8_BAR;
      PG8_LDA(At, 0, 1); PG8_STAGE(PG8_SA(0, 0), a2, voffA);
      PG8_BAR; PG8_WAIT_L(0); PG8_MMA(1, 0, At, B0); PG8_BAR; PG8_SCHED;
      PG8_STAGE(PG8_SB(0, 1), b2 + hstep, voffB);
      PG8_WAIT_V(6); PG8_BAR; PG8_MMA(1, 1, At, B1); PG8_BAR;
      PG8_LDB(B0, 1, 0); PG8_SCHED; PG8_LDA(At, 1, 0); PG8_STAGE(PG8_SA(0, 1), a2 + hstep, voffA);
      PG8_WAIT_L(8); PG8_BAR; PG8_WAIT_L(0); PG8_MMA(0, 0, At, B0); PG8_BAR; PG8_SCHED;
      PG8_LDB(B1, 1, 1); PG8_STAGE(PG8_SB(1, 0), b3, voffB);
      PG8_BAR; PG8_WAIT_L(0); PG8_MMA(0, 1, At, B1); PG8_BAR;
      PG8_LDA(At, 1, 1); PG8_STAGE(PG8_SA(1, 0), a3, voffA);
      PG8_BAR; PG8_WAIT_L(0); PG8_MMA(1, 0, At, B0); PG8_BAR; PG8_SCHED;
      PG8_STAGE(PG8_SB(1, 1), b3 + hstep, voffB);
      PG8_WAIT_V(6); PG8_BAR; PG8_MMA(1, 1, At, B1); PG8_BAR;
    }
    E(acc, cur, wr, wc, fr, fq);
    if (!has_next) break;
#pragma unroll
    for (int a = 0; a < 2; ++a)
#pragma unroll
      for (int b = 0; b < 2; ++b)
#pragma unroll
        for (int m = 0; m < 4; ++m)
#pragma unroll
          for (int n = 0; n < 2; ++n) acc[a][b][m][n] = (f32x4){0.f, 0.f, 0.f, 0.f};
    cur = nxt; cA = nA; cB = nB; ++ui;
  }
  PG8_WAIT_V(0);
  if (wr == 0) PG8_BAR;
  PG8_BAR;
#undef PG8_SA
#undef PG8_SB
#undef PG8_STAGE
#undef PG8_LDA
#undef PG8_LDB
#undef PG8_MMA
#undef PG8_WAIT_V
#undef PG8_WAIT_L
#undef PG8_BAR
#undef PG8_SCHED
}
}

template <class Epi> DI void run_gemm(unsigned char* smem, const bf16_t* A, const bf16_t* Bt, int M, int N, int K, const Epi& E, int wv) {
  pg8::Gemm g{A, Bt, M, N, K}; pg8::StaticOrder S; S.init(M, N, (int)gridDim.x, (int)blockIdx.x);
  pg8::gemm_phase<Epi>((LAS unsigned char*)smem, g, S, E, wv);
  __syncthreads();
}

DI const float* xrow_in(const Params& p, int layer, int row) {
  if (layer == 0) return row < 2 * SEQ ? p.x_prompt + (size_t)row * DM : p.x_sample + (size_t)(row - 2 * SEQ) * DM;
  return p.out + (size_t)row * DM;
}
DI void norm_rows(const Params& p, int layer, int wv) {
  const int tidq = tid_of(wv), wid = tidq >> 6, lane = tidq & 63;
  bf16_t* xb = (bf16_t*)(p.ws + WS_XB); float* rstd = (float*)(p.ws + WS_RSTD);
  for (int row = blockIdx.x * 8 + wid; row < NTOK; row += gridDim.x * 8) {
    const float* xr = xrow_in(p, layer, row);
    f32x4 v[4]; float ss = 0.f;
#pragma unroll
    for (int i = 0; i < 4; ++i) { v[i] = *(const f32x4*)(xr + i * 256 + lane * 4); ss += v[i][0] * v[i][0] + v[i][1] * v[i][1] + v[i][2] * v[i][2] + v[i][3] * v[i][3]; }
    ss = wave_sum(ss);
    if (lane == 0) rstd[row] = rsqrtf(ss * (1.f / DM) + EPS);
#pragma unroll
    for (int i = 0; i < 4; ++i) { u32x2 w = {cvt2(v[i][0], v[i][1]), cvt2(v[i][2], v[i][3])}; *(u32x2*)(xb + (size_t)row * DM + i * 256 + lane * 4) = w; }
  }
}
DI void rstd_rows(const Params& p, int wv) {
  const int tid = tid_of(wv);
  const float* xs = (const float*)(p.ws + WS_XSSP); float* rstd = (float*)(p.ws + WS_RSTD);
  for (int row = blockIdx.x * 512 + tid; row < NTOK; row += gridDim.x * 512) {
    const f32x4* vp = (const f32x4*)(xs + (size_t)row * 16); const f32x4 a = (vp[0] + vp[1]) + (vp[2] + vp[3]);
    rstd[row] = rsqrtf(((a[0] + a[1]) + (a[2] + a[3])) * (1.f / DM) + EPS); }
}
DI void conv_weight_T(unsigned char* smem, const float* W, int K, int N, int Npad, bf16_t* Bt, const float* gk, int nscale, float cscale, int wv) {
  float* tile = (float*)smem;
  const int tid = tid_of(wv), ntn = Npad / 64, ntk = K / 64, ntiles = ntn * ntk;
  for (int t = blockIdx.x; t < ntiles; t += gridDim.x) {
    const int kt = t % ntk, nt = t / ntk, k0 = kt * 64, n0 = nt * 64;
    __syncthreads();
#pragma unroll
    for (int i = 0; i < 2; ++i) {
      const int kk = (tid >> 4) + 32 * i, nn = (tid & 15) * 4; const float gs = gk ? gk[k0 + kk] : 1.f;
      f32x4 wv4 = {0.f, 0.f, 0.f, 0.f}; if (n0 + nn < N) wv4 = *(const f32x4*)(W + (size_t)(k0 + kk) * N + n0 + nn);
      const float cs = gs * (n0 + nn < nscale ? cscale : 1.f);
#pragma unroll
      for (int e = 0; e < 4; ++e) tile[kk * 65 + nn + e] = wv4[e] * cs;
    }
    __syncthreads();
    const int n = tid >> 3, k8 = (tid & 7) * 8;
    float a[8];
#pragma unroll
    for (int e = 0; e < 8; ++e) a[e] = tile[(k8 + e) * 65 + n];
    *(bf16x8*)(Bt + (size_t)(n0 + n) * K + k0 + k8) = pack8(a[0], a[1], a[2], a[3], a[4], a[5], a[6], a[7]);
  }
  __syncthreads();
}

DI void sgu_phase(const Params& p, unsigned char* smem, int seq, int j, int wv) {
  constexpr int RS = 576, SVS = 528;
  const int tid = tid_of(wv), wid = tid >> 6, lane = tid & 63, r32 = lane & 31, hi = lane >> 5;
  const bf16_t* UVZ = (const bf16_t*)(p.ws + WS_ACT); bf16_t* Y = (bf16_t*)(p.ws + WS_Y);
  const float* vss = (const float*)(p.ws + WS_VSS); float* rv_l = (float*)(smem + 128 * RS);
  const float* w_s = p.a_w_s + (size_t)j * 8 * 128 * 128; const float* b_s = p.a_b_s + (size_t)j * 8 * 128; const float* v_g = p.a_v_g + (size_t)j * DIN;
  const unsigned img = (unsigned)(size_t)(LAS unsigned char*)smem;
  const int qt = wid & 3, ch = wid >> 2;
  const int q4 = (lane & 15) >> 2, p4 = lane & 3, blk = (lane >> 4) & 1;
  bf16x8 af[8]; int g_loaded = -1;
#pragma unroll
  for (int s = 0; s < 8; ++s) af[s] = (bf16x8){};
  for (int item = blockIdx.x; item < 1024; item += gridDim.x) {
    const int n = item >> 3, g = item & 7, tok0 = n * 128;
    __syncthreads();
    if (tid < 128) { const f32x4* vp = (const f32x4*)(vss + (size_t)(tok0 + tid) * 32); f32x4 a = vp[0];
#pragma unroll
      for (int k = 1; k < 8; ++k) a += vp[k];
      rv_l[tid] = rsqrtf(((a[0] + a[1]) + (a[2] + a[3])) * (1.f / DIN) + EPS); }
    __syncthreads();
    { const int cg8 = (tid & 31) * 8; float gv[8];
#pragma unroll
      for (int e = 0; e < 8; ++e) gv[e] = v_g[g * 256 + cg8 + e];
#pragma unroll
      for (int i = 0; i < 8; ++i) { const int pp = (tid >> 5) + 16 * i; const float rv = rv_l[pp];
        const u32x4 w = *(const u32x4*)(UVZ + (size_t)(tok0 + pp) * NA + 2048 + g * 256 + cg8);
        const bf16x8 o = pack8(bflo(w.x) * rv * gv[0], bfhi(w.x) * rv * gv[1], bflo(w.y) * rv * gv[2], bfhi(w.y) * rv * gv[3], bflo(w.z) * rv * gv[4], bfhi(w.z) * rv * gv[5], bflo(w.w) * rv * gv[6], bfhi(w.w) * rv * gv[7]);
        *(bf16x8*)(smem + pp * RS + cg8 * 2) = o; } }
    if (g != g_loaded) { g_loaded = g;
      const float* wr_ = w_s + ((size_t)g * 128 + qt * 32 + r32) * 128 + hi * 8;
#pragma unroll
      for (int s = 0; s < 8; ++s) { const f32x4 a = *(const f32x4*)(wr_ + s * 16), b = *(const f32x4*)(wr_ + s * 16 + 4); af[s] = pack8(a[0], a[1], a[2], a[3], b[0], b[1], b[2], b[3]); } }
    __syncthreads();
    f32x16 acc[4];
#pragma unroll
    for (int cb = 0; cb < 4; ++cb) { acc[cb] = (f32x16){};
      const unsigned base = img + (8 * hi + q4) * RS + (128 * ch + 32 * cb + 16 * blk + 4 * p4) * 2;
      s16x4 lo[8], hh[8];
#pragma unroll
      for (int s = 0; s < 8; ++s) { lo[s] = tr_read0(base + 16 * s * RS); hh[s] = tr_read0(base + (16 * s + 4) * RS); }
      LGKM0(); SBAR();
#pragma unroll
      for (int s = 0; s < 8; ++s) acc[cb] = MFMA32(af[s], PK8(lo[s], hh[s]), acc[cb]);
    }
    { unsigned char* sv_l = smem + 128 * RS + 512;
#pragma unroll
      for (int i = 0; i < 16; ++i) { const int q = qt * 32 + crow(i, hi); const float bs = b_s[g * 128 + q];
#pragma unroll
        for (int cb = 0; cb < 4; ++cb) *(bf16_t*)(sv_l + q * SVS + (ch * 128 + cb * 32 + r32) * 2) = f2bf(acc[cb][i] + bs); }
      __syncthreads();
#pragma unroll
      for (int i = 0; i < 8; ++i) { const int q = (tid >> 5) + 16 * i, c8 = (tid & 31) * 8; const size_t ro = (size_t)(tok0 + q) * NA + g * 256 + c8;
        const u32x4 sv = *(const u32x4*)(sv_l + q * SVS + c8 * 2), u = *(const u32x4*)(UVZ + ro), z = *(const u32x4*)(UVZ + ro + 4096);
        *(bf16x8*)(Y + (size_t)(tok0 + q) * DIN + g * 256 + c8) = pack8(
          bflo(u.x) * bflo(sv.x) * silu(bflo(z.x)), bfhi(u.x) * bfhi(sv.x) * silu(bfhi(z.x)), bflo(u.y) * bflo(sv.y) * silu(bflo(z.y)), bfhi(u.y) * bfhi(sv.y) * silu(bfhi(z.y)),
          bflo(u.z) * bflo(sv.z) * silu(bflo(z.z)), bfhi(u.z) * bfhi(sv.z) * silu(bfhi(z.z)), bflo(u.w) * bflo(sv.w) * silu(bflo(z.w)), bfhi(u.w) * bfhi(sv.w) * silu(bfhi(z.w))); } }
  }
  __syncthreads();
}

constexpr size_t B_QT = 168 * MiB, B_KT = 200 * MiB, B_OB = 232 * MiB;
DI int gla_pos(int dir, int tau) { return dir ? (SEQ - 1 - tau) : tau; }
DI void gla_prep_phase(const Params& p, unsigned char* smem, int jb, int wv) {
  float* a_l = (float*)smem; float* seg_l = (float*)(smem + 4096); float* rl_l = (float*)(smem + 6144);
  const int tid = tid_of(wv);
  const bf16_t* X = (const bf16_t*)(p.ws + WS_ACT);
  bf16_t* QT = (bf16_t*)(p.ws + WS_ACT + B_QT); bf16_t* KT = (bf16_t*)(p.ws + WS_ACT + B_KT);
  float* Ev = (float*)(p.ws + WS_GLAE);
  for (int item = blockIdx.x; item < 2048; item += gridDim.x) {
    const int chunk = item & 255, hd = (item >> 8) & 3, dir = item >> 10, tau0 = chunk * 64;
    __syncthreads();
    if (tid < 128) { const int t = tid >> 1, hf = tid & 1; const int pos = gla_pos(dir, tau0 + t);
      const u32x4 w = *(const u32x4*)(X + (size_t)pos * NB + 5120 + dir * 16 + hf * 8);
      float* d = a_l + t * 16 + hf * 8; d[0] = bflo(w.x); d[1] = bfhi(w.x); d[2] = bflo(w.y); d[3] = bfhi(w.y); d[4] = bflo(w.z); d[5] = bfhi(w.z); d[6] = bflo(w.w); d[7] = bfhi(w.w); }
    const int d = tid & 127, tq = tid >> 7;
    float qv[16], kv[16];
#pragma unroll
    for (int tt = 0; tt < 16; ++tt) { const int pos = gla_pos(dir, tau0 + tq * 16 + tt);
      qv[tt] = bf2f(X[(size_t)pos * NB + hd * 128 + d]); kv[tt] = bf2f(X[(size_t)pos * NB + 512 + hd * 128 + d]); }
    float wg[16];
#pragma unroll
    for (int r = 0; r < 16; ++r) wg[r] = p.b_w_gate[(((size_t)jb * 2 + dir) * 16 + r) * 512 + hd * 128 + d];
    const float gb = p.b_gate_bias[((size_t)jb * 2 + dir) * 512 + hd * 128 + d];
    __syncthreads();
    float cum[16]; float run = 0.f;
#pragma unroll
    for (int tt = 0; tt < 16; ++tt) { const float* ar = a_l + (tq * 16 + tt) * 16; float pre = gb;
#pragma unroll
      for (int r = 0; r < 16; ++r) pre += ar[r] * wg[r];
      const float ls = fminf(pre, 0.f) - __logf(1.f + __expf(-fabsf(pre)));
      run += ls * (1.f / 16.f); cum[tt] = run; }
    seg_l[tq * 128 + d] = run;
    __syncthreads();
    float off = 0.f;
    for (int q = 0; q < tq; ++q) off += seg_l[q * 128 + d];
#pragma unroll
    for (int tt = 0; tt < 16; ++tt) cum[tt] += off;
    if (tq == 2) rl_l[d] = cum[0];
    if (tq == 3) rl_l[128 + d] = cum[15];
    __syncthreads();
    const float ref = rl_l[d], last = rl_l[128 + d];
    if (tq == 0) { float* e = Ev + ((((size_t)dir * 4 + hd) * 256 + chunk) * 3) * 128; e[d] = __expf(ref); e[128 + d] = __expf(last - ref); e[256 + d] = __expf(last); }
    unsigned char* qt_l = smem + 8192; unsigned char* kt_l = smem + 8192 + 64 * 272;
#pragma unroll
    for (int tt = 0; tt < 16; ++tt) { const int t = tq * 16 + tt;
      *(bf16_t*)(qt_l + t * 272 + d * 2) = f2bf(qv[tt] * __expf(cum[tt] - ref)); *(bf16_t*)(kt_l + t * 272 + d * 2) = f2bf(kv[tt] * __expf(ref - cum[tt])); }
    __syncthreads();
    { const size_t gb0 = (((size_t)dir * 4 + hd) * SEQ + tau0) * 128;
#pragma unroll
      for (int i = 0; i < 2; ++i) { const int idx = tid + 512 * i, row = idx >> 4, c16 = idx & 15;
        *(u32x4*)(QT + gb0 + row * 128 + c16 * 8) = *(const u32x4*)(qt_l + row * 272 + c16 * 16); *(u32x4*)(KT + gb0 + row * 128 + c16 * 8) = *(const u32x4*)(kt_l + row * 272 + c16 * 16); } }
  }
  __syncthreads();
}

DI void gla_chain_phase(const Params& p, unsigned char* smem, int wv) {
  constexpr int RSQ = 272, RSK = 320, RSV = 80, STB = 44544, PRB = 6 * 4096;
  constexpr int OQ = 0, OK = 17408, OV = 37888, OE = 43008;
  const int tid = tid_of(wv), wid = __builtin_amdgcn_readfirstlane(tid >> 6), lane = tid & 63, r32 = lane & 31, hi = lane >> 5;
  const int q4 = (lane & 15) >> 2, p4 = lane & 3, blk = (lane >> 4) & 1;
  const unsigned lbase = (unsigned)(size_t)(LAS unsigned char*)smem;
  const bf16_t* X = (const bf16_t*)(p.ws + WS_ACT);
  const bf16_t* QT = (const bf16_t*)(p.ws + WS_ACT + B_QT); const bf16_t* KT = (const bf16_t*)(p.ws + WS_ACT + B_KT);
  const float* Ev = (const float*)(p.ws + WS_GLAE);
  for (int chain = blockIdx.x; chain < 128; chain += gridDim.x) {
    const int slice = (chain >> 3) & 15, hd = chain & 3, dir = (chain >> 2) & 1, vc0 = hd * 512 + slice * 32;
    bf16_t* Od = (bf16_t*)(dir ? (p.ws + WS_ACT + B_OB) : (p.ws + WS_Y));
    __syncthreads();
    if (wid >= 4) {
      const int tp = tid - 256;
      const bf16_t* qsrc = QT + ((size_t)dir * 4 + hd) * SEQ * 128; const bf16_t* ksrc = KT + ((size_t)dir * 4 + hd) * SEQ * 128;
      const float* esrc = Ev + (((size_t)dir * 4 + hd) * 256) * 384;
      u32x4 rq[4], rk[4], rv, re;
      auto gload = [&](int chunk) {
#pragma unroll
        for (int i = 0; i < 4; ++i) { const int idx = tp + 256 * i; rq[i] = *(const u32x4*)(qsrc + (size_t)chunk * 64 * 128 + idx * 8); rk[i] = *(const u32x4*)(ksrc + (size_t)chunk * 64 * 128 + idx * 8); }
        rv = *(const u32x4*)(X + (size_t)gla_pos(dir, chunk * 64 + (tp >> 2)) * NB + 1024 + vc0 + (tp & 3) * 8);
        if (tp < 96) re = *(const u32x4*)(esrc + (size_t)chunk * 384 + tp * 4);
      };
      auto lwrite = [&](int b) { unsigned char* bb = smem + b * STB;
#pragma unroll
        for (int i = 0; i < 4; ++i) { const int idx = tp + 256 * i, row = idx >> 4, c16 = idx & 15; *(u32x4*)(bb + OQ + row * RSQ + c16 * 16) = rq[i]; *(u32x4*)(bb + OK + row * RSK + c16 * 16) = rk[i]; }
        *(u32x4*)(bb + OV + (tp >> 2) * RSV + (tp & 3) * 16) = rv;
        if (tp < 96) *(u32x4*)(bb + OE + tp * 16) = re;
      };
      auto finish = [&](int cc) { const unsigned char* pb = smem + 2 * STB + (cc & 1) * PRB; const int t = tp >> 2, v8 = (tp & 3) * 8;
        float acc[8] = {0.f, 0.f, 0.f, 0.f, 0.f, 0.f, 0.f, 0.f};
#pragma unroll
        for (int w = 0; w < 6; ++w) { if (w == 5 && t < 32) continue;
          const u32x4 pw = *(const u32x4*)(pb + ((w * 64 + t) * 32 + v8) * 2);
          acc[0] += bflo(pw.x); acc[1] += bfhi(pw.x); acc[2] += bflo(pw.y); acc[3] += bfhi(pw.y); acc[4] += bflo(pw.z); acc[5] += bfhi(pw.z); acc[6] += bflo(pw.w); acc[7] += bfhi(pw.w); }
        *(bf16x8*)(Od + (size_t)gla_pos(dir, cc * 64 + t) * DIN + vc0 + v8) = pack8(acc[0], acc[1], acc[2], acc[3], acc[4], acc[5], acc[6], acc[7]); };
      auto intra = [&](int c) { const int a = (wid == 6) ? 1 : 0, b = (wid == 4) ? 0 : 1;
        const unsigned char* bb = smem + (c & 1) * STB; unsigned char* pb = smem + 2 * STB + (c & 1) * PRB;
        f32x16 x = {};
#pragma unroll
        for (int ks = 0; ks < 8; ++ks) { const int cb = (16 * ks + 8 * hi) * 2;
          const bf16x8 kf = *(const bf16x8*)(bb + OK + (32 * a + r32) * RSK + cb), qf = *(const bf16x8*)(bb + OQ + (32 * b + r32) * RSQ + cb);
          x = MFMA32(kf, qf, x); if ((ks & 3) == 3) SBAR(); }
        if (a == b) {
#pragma unroll
          for (int i = 0; i < 16; ++i) { const int sidx = crow(i, hi); const bool keep = dir ? (sidx < r32) : (sidx <= r32); x[i] = keep ? x[i] : 0.f; } }
        bf16x8 pf[2];
#pragma unroll
        for (int st = 0; st < 2; ++st) pf[st] = pack8(x[8 * st], x[8 * st + 1], x[8 * st + 2], x[8 * st + 3], x[8 * st + 4], x[8 * st + 5], x[8 * st + 6], x[8 * st + 7]);
        const unsigned vb_ = lbase + (c & 1) * STB + OV + (32 * a + 4 * hi + q4) * RSV + (16 * blk + 4 * p4) * 2;
        s16x4 lo[2], hh[2];
#pragma unroll
        for (int st = 0; st < 2; ++st) { lo[st] = tr_read0(vb_ + (16 * st) * RSV); hh[st] = tr_read0(vb_ + (16 * st + 8) * RSV); }
        LGKM0(); SBAR();
        f32x16 z = {};
        z = MFMA32(pf[0], PK8(lo[0], hh[0]), z); z = MFMA32(pf[1], PK8(lo[1], hh[1]), z);
        const int slot = 4 + a;
#pragma unroll
        for (int i = 0; i < 16; ++i) *(bf16_t*)(pb + ((slot * 64 + 32 * b + crow(i, hi)) * 32 + r32) * 2) = f2bf(z[i]);
      };
      gload(0); lwrite(0); gload(1);
      __syncthreads();
      for (int c = 0; c < 256; ++c) {
        if (c + 1 < 256) { lwrite((c + 1) & 1); if (c + 2 < 256) gload(c + 2); }
        if (c > 0) finish(c - 1);
        if (wid < 7) intra(c);
        __syncthreads();
      }
      finish(255);
    } else {
      const int w = wid;
      f32x16 S = {};
      __syncthreads();
      for (int c = 0; c < 256; ++c) {
        const unsigned char* bb = smem + (c & 1) * STB; const float* e_l = (const float*)(bb + OE); unsigned char* pb = smem + 2 * STB + (c & 1) * PRB;
        float sc[16];
#pragma unroll
        for (int i = 0; i < 16; ++i) sc[i] = S[i] * e_l[32 * w + crow(i, hi)];
        f32x16 y0 = {}, y1 = {};
#pragma unroll
        for (int st = 0; st < 2; ++st) {
          const bf16x8 sb = pack8(sc[8 * st], sc[8 * st + 1], sc[8 * st + 2], sc[8 * st + 3], sc[8 * st + 4], sc[8 * st + 5], sc[8 * st + 6], sc[8 * st + 7]);
          const int dof = (32 * w + 16 * st + 4 * hi) * 2;
          const s16x4 a0l = *(const s16x4*)(bb + OQ + r32 * RSQ + dof), a0h = *(const s16x4*)(bb + OQ + r32 * RSQ + dof + 16);
          const s16x4 a1l = *(const s16x4*)(bb + OQ + (32 + r32) * RSQ + dof), a1h = *(const s16x4*)(bb + OQ + (32 + r32) * RSQ + dof + 16);
          y0 = MFMA32(PK8(a0l, a0h), sb, y0); y1 = MFMA32(PK8(a1l, a1h), sb, y1);
        }
        SBAR();
        f32x16 U = {};
        { const unsigned ka = lbase + (c & 1) * STB + OK + (8 * hi + q4) * RSK + (32 * w + 16 * blk + 4 * p4) * 2, va = lbase + (c & 1) * STB + OV + (8 * hi + q4) * RSV + (16 * blk + 4 * p4) * 2;
          s16x4 al[4], ah[4], bl[4], bh[4];
#pragma unroll
          for (int ks = 0; ks < 4; ++ks) { al[ks] = tr_read0(ka + (16 * ks) * RSK); ah[ks] = tr_read0(ka + (16 * ks + 4) * RSK); bl[ks] = tr_read0(va + (16 * ks) * RSV); bh[ks] = tr_read0(va + (16 * ks + 4) * RSV); }
          LGKM0(); SBAR();
#pragma unroll
          for (int ks = 0; ks < 4; ++ks) U = MFMA32(PK8(al[ks], ah[ks]), PK8(bl[ks], bh[ks]), U); }
#pragma unroll
        for (int i = 0; i < 16; ++i) { *(bf16_t*)(pb + ((w * 64 + crow(i, hi)) * 32 + r32) * 2) = f2bf(y0[i]); *(bf16_t*)(pb + ((w * 64 + 32 + crow(i, hi)) * 32 + r32) * 2) = f2bf(y1[i]); }
        SBAR();
#pragma unroll
        for (int i = 0; i < 16; ++i) { const int dd = 32 * w + crow(i, hi); S[i] = S[i] * e_l[256 + dd] + U[i] * e_l[128 + dd]; }
        __syncthreads();
      }
    }
  }
  __syncthreads();
}

DI void gla_post_phase(const Params& p, int jb, int wv) {
  const int tidq = tid_of(wv), wid = tidq >> 6, lane = tidq & 63;
  const bf16_t* X = (const bf16_t*)(p.ws + WS_ACT); bf16_t* Y = (bf16_t*)(p.ws + WS_Y); const bf16_t* OB = (const bf16_t*)(p.ws + WS_ACT + B_OB);
  const float* og = p.b_o_g + (size_t)jb * 512;
  float gg[8];
#pragma unroll
  for (int e = 0; e < 8; ++e) gg[e] = og[lane * 8 + e];
  for (int it0 = blockIdx.x * 8 + wid; it0 < SEQ * 4; it0 += gridDim.x * 8 * 4) {
    u32x4 a[4], b[4], g[4];
#pragma unroll
    for (int u = 0; u < 4; ++u) { const int it = it0 + u * gridDim.x * 8; if (it < SEQ * 4) { const int tok = it >> 2, hd = it & 3; const size_t o = (size_t)tok * DIN + hd * 512 + lane * 8;
        a[u] = *(const u32x4*)(Y + o); b[u] = *(const u32x4*)(OB + o); g[u] = *(const u32x4*)(X + (size_t)tok * NB + 3072 + hd * 512 + lane * 8); } }
#pragma unroll
    for (int u = 0; u < 4; ++u) { const int it = it0 + u * gridDim.x * 8; if (it < SEQ * 4) { const int tok = it >> 2, hd = it & 3; const size_t o = (size_t)tok * DIN + hd * 512 + lane * 8;
        float v[8] = {bflo(a[u].x) + bflo(b[u].x), bfhi(a[u].x) + bfhi(b[u].x), bflo(a[u].y) + bflo(b[u].y), bfhi(a[u].y) + bfhi(b[u].y), bflo(a[u].z) + bflo(b[u].z), bfhi(a[u].z) + bfhi(b[u].z), bflo(a[u].w) + bflo(b[u].w), bfhi(a[u].w) + bfhi(b[u].w)};
        const float gv[8] = {bflo(g[u].x), bfhi(g[u].x), bflo(g[u].y), bfhi(g[u].y), bflo(g[u].z), bfhi(g[u].z), bflo(g[u].w), bfhi(g[u].w)};
        float ss = 0.f;
#pragma unroll
        for (int e = 0; e < 8; ++e) ss += v[e] * v[e];
        ss = wave_sum(ss); const float r = rsqrtf(ss * (1.f / 512.f) + EPS);
#pragma unroll
        for (int e = 0; e < 8; ++e) v[e] = v[e] * r * gg[e] * silu(gv[e]);
        *(bf16x8*)(Y + o) = pack8(v[0], v[1], v[2], v[3], v[4], v[5], v[6], v[7]); } }
  }
}

DI void qknorm_phase(const Params& p, unsigned char* smem, int jc, int wv) {
  const int tidq = tid_of(wv), wid = tidq >> 6, lane = tidq & 63, sub = lane >> 4, l16 = lane & 15;
  bf16_t* X = (bf16_t*)(p.ws + WS_ACT);
  float gq[8], gk[8];
#pragma unroll
  for (int e = 0; e < 8; ++e) { gq[e] = p.c_q_g[(size_t)jc * 128 + l16 * 8 + e] * (0.08838834764831845f * 1.4426950408889634f); gk[e] = p.c_k_g[(size_t)jc * 128 + l16 * 8 + e]; }
  float mq = 0.f, mk = 0.f;
  for (int it0 = blockIdx.x * 8 + wid; it0 < SEQ * 8; it0 += gridDim.x * 8 * 4) {
    u32x4 w4[4];
#pragma unroll
    for (int u = 0; u < 4; ++u) { const int it = it0 + u * gridDim.x * 8; if (it < SEQ * 8) { const int row = it >> 3, gi = (it & 7) * 4 + sub; w4[u] = *(const u32x4*)(X + (size_t)row * NC + gi * 128 + l16 * 8); } }
#pragma unroll
    for (int u = 0; u < 4; ++u) { const int it = it0 + u * gridDim.x * 8; if (it < SEQ * 8) { const int row = it >> 3, gi = (it & 7) * 4 + sub;
        bf16_t* ptr = X + (size_t)row * NC + gi * 128 + l16 * 8; const u32x4 w = w4[u];
        float v[8] = {bflo(w.x), bfhi(w.x), bflo(w.y), bfhi(w.y), bflo(w.z), bfhi(w.z), bflo(w.w), bfhi(w.w)};
        float ss = 0.f;
#pragma unroll
        for (int e = 0; e < 8; ++e) ss += v[e] * v[e];
        ss += __shfl_xor(ss, 1); ss += __shfl_xor(ss, 2); ss += __shfl_xor(ss, 4); ss += __shfl_xor(ss, 8);
        const float r = rsqrtf(ss * (1.f / 128.f) + EPS); const bool isq = gi < 16;
#pragma unroll
        for (int e = 0; e < 8; ++e) v[e] = v[e] * r * (isq ? gq[e] : gk[e]);
        const bf16x8 ov = pack8(v[0], v[1], v[2], v[3], v[4], v[5], v[6], v[7]);
        *(bf16x8*)ptr = ov;
        { const u32x4 ow = __builtin_bit_cast(u32x4, ov);
          float n2 = bflo(ow.x) * bflo(ow.x) + bfhi(ow.x) * bfhi(ow.x) + bflo(ow.y) * bflo(ow.y) + bfhi(ow.y) * bfhi(ow.y) + bflo(ow.z) * bflo(ow.z) + bfhi(ow.z) * bfhi(ow.z) + bflo(ow.w) * bflo(ow.w) + bfhi(ow.w) * bfhi(ow.w);
          n2 += __shfl_xor(n2, 1); n2 += __shfl_xor(n2, 2); n2 += __shfl_xor(n2, 4); n2 += __shfl_xor(n2, 8);
          if (isq) mq = fmaxf(mq, n2); else mk = fmaxf(mk, n2); } } }
  }
  { float* red = (float*)smem;
    mq = fmaxf(mq, __shfl_xor(mq, 16)); mq = fmaxf(mq, __shfl_xor(mq, 32)); mk = fmaxf(mk, __shfl_xor(mk, 16)); mk = fmaxf(mk, __shfl_xor(mk, 32));
    __syncthreads();
    if (lane == 0) { red[wid] = mq; red[8 + wid] = mk; }
    __syncthreads();
    if (tidq == 0) { float a = red[0], b = red[8];
      for (int i = 1; i < 8; ++i) { a = fmaxf(a, red[i]); b = fmaxf(b, red[8 + i]); }
      unsigned* nm = (unsigned*)(p.ws + WS_CTR) + 16;
      atomicMax(nm, __float_as_uint(a)); atomicMax(nm + 1, __float_as_uint(b)); }
    __syncthreads(); }
}

#define KSWZ(row, colB) ((row) * 256 + ((colB) ^ (((row) & 7) << 4)))
DI int v_rd_base(int lane) { return ((lane & 3) << 3) | (((lane >> 2) & 3) << 6) | (((lane >> 4) & 1) << 5) | (((lane >> 5) & 1) << 8); }
constexpr int v_rd_off(int d0, int ks, int half) { return d0 * 512 + ks * 4096 + half * 2048; }

template <int D0, int KH> DI void pv_half(f32x16& od, int vb, bf16x8 pa0, bf16x8 pa1) {
  const s16x4 l0 = tr_read<v_rd_off(D0, 2 * KH, 0)>(vb), h0 = tr_read<v_rd_off(D0, 2 * KH, 1)>(vb), l1 = tr_read<v_rd_off(D0, 2 * KH + 1, 0)>(vb), h1 = tr_read<v_rd_off(D0, 2 * KH + 1, 1)>(vb);
  LGKM0(); SBAR();
  od = MFMA32(pa0, PK8(l0, h0), od); od = MFMA32(pa1, PK8(l1, h1), od);
}
DI void sm_half(f32x16& p0, float base, float slope2, float& l_reg, bf16x8& pa0, bf16x8& pa1) {
#pragma unroll
  for (int r = 0; r < 16; ++r) { const float dl = (float)((r & 3) + 8 * (r >> 2)); p0[r] = __builtin_amdgcn_exp2f(fmaf(-slope2, fabsf(base - dl), p0[r])); }
  float ps = 0.f;
#pragma unroll
  for (int r = 0; r < 16; ++r) ps += p0[r];
  { auto rr = __builtin_amdgcn_permlane32_swap(__float_as_uint(ps), __float_as_uint(ps), false, false);
    ps = __uint_as_float(rr[0]) + __uint_as_float(rr[1]); }
  l_reg += ps;
#define PK4(P, BASE, OUT) do { unsigned a0 = cvt2(P[BASE + 0], P[BASE + 1]), a1 = cvt2(P[BASE + 2], P[BASE + 3]); \
    unsigned b0 = cvt2(P[BASE + 4], P[BASE + 5]), b1 = cvt2(P[BASE + 6], P[BASE + 7]); \
    auto r0 = __builtin_amdgcn_permlane32_swap(a0, b0, false, false); auto r1 = __builtin_amdgcn_permlane32_swap(a1, b1, false, false); \
    u32x4 w = {r0[0], r1[0], r0[1], r1[1]}; OUT = __builtin_bit_cast(bf16x8, w); } while (0)
  PK4(p0, 0, pa0); PK4(p0, 8, pa1);
#undef PK4
}
DI void att_tile(const unsigned char* Ks, const bf16x8 (&qr)[8], f32x16 (&o)[8], float base, float slope2, float negM, float& l_reg, int r32, int hi, int vb0, int vb1) {
  f32x16 p0, p1;
#pragma unroll
  for (int i = 0; i < 16; ++i) { p0[i] = negM; p1[i] = negM; }
#pragma unroll
  for (int d0 = 0; d0 < 8; ++d0) { const int cb = (d0 * 16 + hi * 8) * 2;
    const bf16x8 b0 = *(const bf16x8*)(Ks + KSWZ(r32, cb)); const bf16x8 b1 = *(const bf16x8*)(Ks + KSWZ(32 + r32, cb));
    p0 = MFMA32(b0, qr[d0], p0); p1 = MFMA32(b1, qr[d0], p1); if ((d0 & 3) == 3) SBAR(); }
  bf16x8 pa0, pa1;
  sm_half(p0, base, slope2, l_reg, pa0, pa1);
  pv_half<0, 0>(o[0], vb0, pa0, pa1); pv_half<1, 0>(o[1], vb0, pa0, pa1); pv_half<2, 0>(o[2], vb0, pa0, pa1); pv_half<3, 0>(o[3], vb0, pa0, pa1);
  pv_half<0, 0>(o[4], vb1, pa0, pa1); pv_half<1, 0>(o[5], vb1, pa0, pa1); pv_half<2, 0>(o[6], vb1, pa0, pa1); pv_half<3, 0>(o[7], vb1, pa0, pa1);
  sm_half(p1, base - 32.f, slope2, l_reg, pa0, pa1);
  pv_half<0, 1>(o[0], vb0, pa0, pa1); pv_half<1, 1>(o[1], vb0, pa0, pa1); pv_half<2, 1>(o[2], vb0, pa0, pa1); pv_half<3, 1>(o[3], vb0, pa0, pa1);
  pv_half<0, 1>(o[4], vb1, pa0, pa1); pv_half<1, 1>(o[5], vb1, pa0, pa1); pv_half<2, 1>(o[6], vb1, pa0, pa1); pv_half<3, 1>(o[7], vb1, pa0, pa1);
}

DI void attn_phase(const Params& p, unsigned char* smem, int jc, float lambda_init, unsigned* ctr, int wv) {
  const int tid = tid_of(wv), wid = __builtin_amdgcn_readfirstlane(tid >> 6), lane = tid & 63, r32 = lane & 31, hi = lane >> 5;
  const int rg = wid & 3, mp = wid >> 2;
  const bf16_t* X = (const bf16_t*)(p.ws + WS_ACT); bf16_t* Y = (bf16_t*)(p.ws + WS_Y);
  LAS unsigned char* lds = (LAS unsigned char*)smem;
  float* wsc = (float*)(smem + 131072 + wid * 256); float* li_l = wsc; float* al_l = wsc + 32;
  float lam_full;
  { const float* lf = p.c_lam + (size_t)jc * 512; float s1 = 0.f, s2 = 0.f;
    for (int i = 0; i < 128; ++i) { s1 += lf[i] * lf[128 + i]; s2 += lf[256 + i] * lf[384 + i]; }
    lam_full = __expf(s1) - __expf(s2) + lambda_init; }
  const unsigned ldsw = (unsigned)wid * 1024u;
  unsigned char* ofs_l = smem + 135168 + wid * 1024;
  { u32x4 ofs;
    unsigned kofs[2], vofs[2];
#pragma unroll
    for (int _i = 0; _i < 2; ++_i) { const int Bo = _i * 8192 + wid * 1024 + lane * 16;
      { const int row = Bo >> 8, chp = (Bo >> 4) & 15, chn = chp ^ (row & 7); kofs[_i] = (unsigned)(row * NC + chn * 8); }
      { const int st = Bo >> 9, e = (Bo & 511) >> 1, kk = (st >> 2) * 8 + (e >> 5), c = (st & 3) * 32 + (e & 31); const int k = (kk & ~0xC) | ((kk & 4) << 1) | ((kk & 8) >> 1); vofs[_i] = (unsigned)(k * NC + c); } }
    ofs.x = kofs[0]; ofs.y = kofs[1]; ofs.z = vofs[0]; ofs.w = vofs[1];
    *(u32x4*)(ofs_l + lane * 16) = ofs; }
#define ATT_LOAD(buf, key0) do { const bf16_t* kb_ = X + (size_t)(key0) * NC + 2048 + head * 256; const bf16_t* vb_ = X + (size_t)(key0) * NC + 4096 + head * 256; \
    const u32x4 ofs_ = *(const u32x4*)(ofs_l + opq(lane) * 16); const unsigned kofs[2] = {ofs_.x, ofs_.y}, vofs[2] = {ofs_.z, ofs_.w}; \
    _Pragma("unroll") for (int _i = 0; _i < 2; ++_i) { \
      __builtin_amdgcn_global_load_lds((const unsigned*)(kb_ + kofs[_i]), (LAS unsigned*)(lds + (buf) * 65536 + ldsw + _i * 8192), 16, 0, 0); \
      __builtin_amdgcn_global_load_lds((const unsigned*)(kb_ + 128 + kofs[_i]), (LAS unsigned*)(lds + (buf) * 65536 + 16384 + ldsw + _i * 8192), 16, 0, 0); \
      __builtin_amdgcn_global_load_lds((const unsigned*)(vb_ + vofs[_i]), (LAS unsigned*)(lds + (buf) * 65536 + 32768 + ldsw + _i * 8192), 16, 0, 0); \
      __builtin_amdgcn_global_load_lds((const unsigned*)(vb_ + 128 + vofs[_i]), (LAS unsigned*)(lds + (buf) * 65536 + 49152 + ldsw + _i * 8192), 16, 0, 0); } } while (0)
  const int vbl = (int)(unsigned)(size_t)lds + v_rd_base(lane);
  const unsigned* nm = (const unsigned*)(p.ws + WS_CTR) + 16;
  const float bound2 = 2.f * 1.01f * sqrtf(__uint_as_float(nm[0]) * __uint_as_float(nm[1])) + 38.f;
  int* item_l = (int*)(smem + 131072 + 2048);
  float* cst_l = (float*)(smem + 131072 + 2048 + 128);
  cst_l[0] = lam_full; cst_l[1] = bound2;
  bool first = true;
  for (;;) {
    __syncthreads();
    if (tid == 0) *item_l = first ? (int)blockIdx.x : (int)(gridDim.x + atomicAdd(ctr, 1u));
    first = false;
    __syncthreads();
    const int item = *item_l;
    if (item >= 1024) break;
    const int head = 7 - (item >> 7), qb = (item & 7) * 16 + ((item >> 3) & 15), q0 = qb * 128;
    const float slope2 = exp2f(-(float)(head + 1)) * 1.4426950408889634f;
    const int qrow = q0 + rg * 32 + r32;
    const float bound2i = cst_l[1];
    const int Wd = (int)ceilf(bound2i / slope2);
    int jt_lo = q0 - Wd - 63; jt_lo = jt_lo < 0 ? 0 : (jt_lo >> 6) + 1;
    int jt_hi = (q0 + 127 + Wd + 63) >> 6; jt_hi = (jt_hi > SEQ / 64 ? SEQ / 64 : jt_hi);
    const int jc0 = q0 >> 6;
    const float L2m = 0.5f * (bound2i - 38.f);
    float* mm_l = (float*)(smem + 131072 + 2048 + 64);
    int dlim = 0x7fffffff;
    auto next_tile = [&](int cur) -> int {
      int cand;
      if (cur == jc0) return jc0 + 1;
      if (cur <= jc0 + 1) { cand = (cur == jc0 + 1) ? jc0 - 1 : cur - 1;
        if (cand >= jt_lo && (q0 - (64 * cand + 63)) < dlim) return cand;
        cand = jc0 + 2; }
      else cand = cur + 1;
      if (cand < jt_hi && (64 * cand - (q0 + 127)) < dlim) return cand;
      return -1; };
    int cur = jc0;
    ATT_LOAD(0, cur * 64);
    bf16x8 qr[8];
    { const int lq = opq(lane); const bf16_t* qp = X + (size_t)(q0 + rg * 32 + (lq & 31)) * NC + head * 256 + mp * 128 + (lq >> 5) * 8;
#pragma unroll
      for (int d0 = 0; d0 < 8; ++d0) qr[d0] = *(const bf16x8*)(qp + d0 * 16); }
    f32x16 o[8];
#pragma unroll
    for (int d = 0; d < 8; ++d) o[d] = (f32x16){};
    float l_reg = 0.f; const float negM = -L2m;
    asm volatile("s_waitcnt vmcnt(0)" ::: "memory");
    __syncthreads();
    for (int it = 0;; ++it) {
      const int buf = it & 1;
      const int nxt = next_tile(cur);
      if (nxt >= 0) ATT_LOAD(buf ^ 1, nxt * 64);
      const unsigned char* Ks = smem + buf * 65536 + mp * 16384;
      const int vb0 = vbl + buf * 65536 + 32768, vb1 = vb0 + 16384;
      const float base = (float)(qrow - 64 * cur - 4 * hi);
      att_tile(Ks, qr, o, base, slope2, negM, l_reg, r32, hi, vb0, vb1);
      if ((it & 3) == 0) { float mw = l_reg; mw = fminf(mw, __shfl_xor(mw, 1)); mw = fminf(mw, __shfl_xor(mw, 2)); mw = fminf(mw, __shfl_xor(mw, 4)); mw = fminf(mw, __shfl_xor(mw, 8)); mw = fminf(mw, __shfl_xor(mw, 16));
        if (lane == 0) mm_l[buf * 8 + wid] = mw; }
      asm volatile("s_waitcnt vmcnt(0)" ::: "memory");
      __syncthreads();
      if (nxt < 0) break;
      if ((it & 3) == 0) { const f32x4 a = *(const f32x4*)(mm_l + buf * 8), b = *(const f32x4*)(mm_l + buf * 8 + 4);
        const float mmin = fminf(fminf(fminf(a[0], a[1]), fminf(a[2], a[3])), fminf(fminf(b[0], b[1]), fminf(b[2], b[3])));
        dlim = __builtin_amdgcn_readfirstlane((int)fminf(ceilf((39.f - __builtin_amdgcn_logf(mmin)) / slope2), 1.0e9f)); }
      cur = nxt;
    }
    const int lee = opq(lane), r32e = lee & 31, hie = lee >> 5;
    if (hie == 0) li_l[r32e] = l_reg; LGKM0();
    {
#pragma unroll
      for (int r = 0; r < 16; ++r) { const float rl = (mp == 1 ? cst_l[0] : 1.f) * __builtin_amdgcn_rcpf(li_l[crow(r, hie)]);
#pragma unroll
        for (int d = 0; d < 8; ++d) o[d][r] *= rl; }
    }
    SBAR();
    float* xch = (float*)smem + (size_t)rg * 8192;
    if (mp == 1) {
#pragma unroll
      for (int d = 0; d < 8; ++d) {
#pragma unroll
        for (int r = 0; r < 16; ++r) xch[(d * 16 + r) * 64 + lane] = o[d][r];
        SBAR(); }
    }
    __syncthreads();
    if (mp == 0) {
      float ss[16];
#pragma unroll
      for (int r = 0; r < 16; ++r) ss[r] = 0.f;
#pragma unroll
      for (int d = 0; d < 8; ++d) {
#pragma unroll
        for (int r = 0; r < 16; ++r) { const float v = o[d][r] - xch[(d * 16 + r) * 64 + lane]; o[d][r] = v; ss[r] = fmaf(v, v, ss[r]); }
        SBAR(); }
#pragma unroll
      for (int r = 0; r < 16; ++r) { float s = ss[r]; s += __shfl_xor(s, 1); s += __shfl_xor(s, 2); s += __shfl_xor(s, 4); s += __shfl_xor(s, 8); s += __shfl_xor(s, 16);
        ss[r] = rsqrtf(s * (1.f / 256.f) + EPS) * (1.f - lambda_init); }
#pragma unroll
      for (int d = 0; d < 8; ++d) { const float ogv = p.c_o_g[(size_t)jc * 256 + d * 32 + r32e];
#pragma unroll
        for (int r = 0; r < 16; ++r) xch[crow(r, hie) * 256 + d * 32 + r32e] = o[d][r] * ss[r] * ogv;
        SBAR(); }
      LGKM0();
      const int le = opq(lane);
      for (int rb = 0; rb < 32; rb += 8) {
        f32x4 v[8]; u32x2 zz[8];
#pragma unroll
        for (int k = 0; k < 8; ++k) { const int row = q0 + rg * 32 + rb + k;
          v[k] = *(const f32x4*)(xch + (rb + k) * 256 + le * 4);
          zz[k] = *(const u32x2*)(X + (size_t)row * NC + 6144 + head * 256 + le * 4); }
#pragma unroll
        for (int k = 0; k < 8; ++k) { const int row = q0 + rg * 32 + rb + k;
          u32x2 w = {cvt2(v[k][0] * silu(bflo(zz[k].x)), v[k][1] * silu(bfhi(zz[k].x))), cvt2(v[k][2] * silu(bflo(zz[k].y)), v[k][3] * silu(bfhi(zz[k].y)))};
          *(u32x2*)(Y + (size_t)row * DIN + head * 256 + le * 4) = w; } }
    }
  }
  __syncthreads();
#undef ATT_LOAD
}

#define XB_TMO      128
#define XB_XCNT(j)  (256  + 64 * (j))
#define XB_XSUB(j)  (1280 + 64 * (j))
#define XB_XGEN(j)  (2304 + 64 * (j))
#define XB_TOP      3328
#define XB_TOPGEN   3392
#define XCD_BAR_WORDS 3456
#define XB_SPIN_CAP (1u << 18)
DI unsigned xb_ld(unsigned* p)              { return __hip_atomic_load(p, __ATOMIC_RELAXED, __HIP_MEMORY_SCOPE_AGENT); }
DI unsigned xb_add(unsigned* p, unsigned v) { return __hip_atomic_fetch_add(p, v, __ATOMIC_RELAXED, __HIP_MEMORY_SCOPE_AGENT); }
DI unsigned xb_xcc_id() { return (unsigned)__builtin_amdgcn_s_getreg((3 << 11) | 20) & 0xFu; }
#define XB_SPIN(cond, bar) do { unsigned _sp = 0; while (cond) { __builtin_amdgcn_s_sleep(1); \
    if ((++_sp & 255u) == 0u) { if (xb_ld(&(bar)[XB_TMO])) break; if (_sp > XB_SPIN_CAP) { atomicAdd(&(bar)[XB_TMO], 1u); break; } } } } while (0)
struct XcdBarrier { unsigned* bar; unsigned x; volatile LAS unsigned* st; };
DI void xcd_barrier_complete(unsigned* bar, unsigned x, unsigned& nloc, unsigned& nx) {
  const unsigned G = gridDim.x * gridDim.y * gridDim.z;
  unsigned sum, cnt, mine, sp = 0u;
  for (;;) {
    sum = 0u; cnt = 0u; mine = 0u;
#pragma unroll
    for (unsigned j = 0; j < 16; ++j) { const unsigned c = xb_ld(&bar[XB_XCNT(j)]); sum += c; cnt += (c > 0u) ? 1u : 0u; mine = (j == x) ? c : mine; }
    if (sum == G) break;
    __builtin_amdgcn_s_sleep(1);
    if ((++sp & 255u) == 0u) { if (xb_ld(&bar[XB_TMO])) break; if (sp > XB_SPIN_CAP) { atomicAdd(&bar[XB_TMO], 1u); break; } }
  }
  nloc = mine > 0u ? mine : 1u; nx = cnt > 0u ? cnt : 1u;
}
DI void gsync(const XcdBarrier& b, int wv) {
  asm volatile("s_waitcnt vmcnt(0) lgkmcnt(0)" ::: "memory");
  __syncthreads();
  if (tid_of(wv) == 0) {
    unsigned* bar = b.bar;
    __builtin_amdgcn_s_waitcnt(0);
    unsigned nloc = b.st[0], nx = b.st[1];
    if (nloc == 0u) { xcd_barrier_complete(bar, b.x, nloc, nx); b.st[0] = nloc; b.st[1] = nx; }
    const unsigned old = xb_add(&bar[XB_XSUB(b.x)], 1u);
    const unsigned gen = old / nloc;
    if (old + 1u == (gen + 1u) * nloc) {
      __builtin_amdgcn_fence(__ATOMIC_RELEASE, "agent");
      asm volatile("s_waitcnt vmcnt(0)" ::: "memory");
      const unsigned og = xb_add(&bar[XB_TOP], 1u);
      const unsigned tg = og / nx;
      if (og + 1u == (tg + 1u) * nx) xb_add(&bar[XB_TOPGEN], 1u);
      else XB_SPIN(xb_ld(&bar[XB_TOPGEN]) == tg, bar);
      __builtin_amdgcn_fence(__ATOMIC_ACQUIRE, "agent");
      xb_add(&bar[XB_XGEN(b.x)], 1u);
      asm volatile("s_waitcnt vmcnt(0)" ::: "memory");
    } else {
      XB_SPIN(xb_ld(&bar[XB_XGEN(b.x)]) == gen, bar);
      __builtin_amdgcn_fence(__ATOMIC_ACQUIRE, "agent");
      asm volatile("s_waitcnt vmcnt(0)" ::: "memory");
    }
  }
  __syncthreads();
}

__global__ void __launch_bounds__(512) mega(Params p) {
  extern __shared__ __attribute__((aligned(16))) unsigned char smem[];
  cg::grid_group grid = cg::this_grid();
  const int wv = __builtin_amdgcn_readfirstlane((int)(threadIdx.x >> 6));
  XcdBarrier xb; xb.bar = (unsigned*)(p.ws + WS_BAR); xb.x = xb_xcc_id(); xb.st = (volatile LAS unsigned*)((LAS unsigned char*)smem + (LDS_BYTES - 16));
  if (threadIdx.x == 0) { xb.st[0] = 0u; xb.st[1] = 0u; (void)xb_add(&xb.bar[XB_XCNT(xb.x)], 1u); }
  __syncthreads();
  bf16_t* Wb = (bf16_t*)(p.ws + WS_W); bf16_t* Wo = (bf16_t*)(p.ws + WS_WOUT);
  bf16_t* XB = (bf16_t*)(p.ws + WS_XB); bf16_t* ACT = (bf16_t*)(p.ws + WS_ACT); bf16_t* Yb = (bf16_t*)(p.ws + WS_Y);
  float* vss = (float*)(p.ws + WS_VSS);
  for (int layer = 0; layer < 4; ++layer) {
    const int kind = layer % 3, j = layer / 3;
    if (layer == 0) norm_rows(p, layer, wv); else rstd_rows(p, wv);
    const float* ng = p.norm_g + (size_t)layer * DM;
    if (kind == 0) {
      conv_weight_T(smem, p.a_w_in + (size_t)j * DM * NA, DM, NA, NA, Wb, ng, 0, 1.f, wv);
      conv_weight_T(smem, p.a_w_out + (size_t)j * DIN * DM, DIN, DM, DM, Wo, nullptr, 0, 1.f, wv);
    } else if (kind == 1) {
      conv_weight_T(smem, p.b_w_in + (size_t)j * DM * 5152, DM, 5152, NB, Wb, ng, 512, 0.08838834764831845f, wv);
      conv_weight_T(smem, p.b_w_out + (size_t)j * DIN * DM, DIN, DM, DM, Wo, nullptr, 0, 1.f, wv);
    } else {
      conv_weight_T(smem, p.c_w_in + (size_t)j * DM * NC, DM, NC, NC, Wb, ng, 0, 1.f, wv);
      conv_weight_T(smem, p.c_w_out + (size_t)j * DIN * DM, DIN, DM, DM, Wo, nullptr, 0, 1.f, wv);
      { const int t8 = tid_of(wv); if (blockIdx.x == 0 && t8 < 32) ((unsigned*)(p.ws + WS_CTR))[t8] = 0u; }
    }
    if (layer == 0) { asm volatile("s_waitcnt vmcnt(0) lgkmcnt(0)" ::: "memory"); grid.sync(); } else gsync(xb, wv);
    for (int step = 0; step <= NSEQ; ++step) {
      if (step > 0) { const int sq = step - 1; float* xo = p.out + (size_t)sq * SEQ * DM;
        const float* xi = (layer == 0) ? (sq < 2 ? p.x_prompt + (size_t)sq * SEQ * DM : p.x_sample) : xo;
        run_gemm(smem, Yb, Wo, SEQ, DM, DIN, pg8::EpiRes{xo, xi, DM, layer < 3 ? XB + (size_t)sq * SEQ * DM : nullptr, (float*)(p.ws + WS_XSSP) + (size_t)sq * SEQ * 16}, wv); }
      if (step < NSEQ) { const bf16_t* xa = XB + (size_t)step * SEQ * DM; const float* rstd = (const float*)(p.ws + WS_RSTD) + (size_t)step * SEQ;
        if (kind == 0) run_gemm(smem, xa, Wb, SEQ, NA, DM, pg8::EpiBf16<true>{ACT, NA, vss, rstd}, wv);
        else if (kind == 1) run_gemm(smem, xa, Wb, SEQ, NB, DM, pg8::EpiBf16<false>{ACT, NB, nullptr, rstd}, wv);
        else run_gemm(smem, xa, Wb, SEQ, NC, DM, pg8::EpiBf16<false>{ACT, NC, nullptr, rstd}, wv); }
      gsync(xb, wv);
      if (step == NSEQ) break;
      const int seq = step;
      if (kind == 0) {
        sgu_phase(p, smem, seq, j, wv); gsync(xb, wv);
      } else if (kind == 1) {
        gla_prep_phase(p, smem, j, wv); gsync(xb, wv);
        gla_chain_phase(p, smem, wv); gsync(xb, wv);
        gla_post_phase(p, j, wv); gsync(xb, wv);
      } else {
        qknorm_phase(p, smem, j, wv); gsync(xb, wv);
        attn_phase(p, smem, j, 0.8f - 0.6f * 0.5488116360940264f, (unsigned*)(p.ws + WS_CTR) + seq, wv); gsync(xb, wv);
      }
    }
  }
}

extern "C" void kernel_launch(void* const* d_in, const int* in_sizes, int n_in, void* d_out, int out_size, void* d_ws, size_t ws_size, hipStream_t stream) {
  static int grid = 0;
  if (grid == 0) {
    if (n_in != 19 || ws_size < WS_END) { fprintf(stderr, "kernel_launch: unexpected n_in %d or ws_size %zu (< %zu)\n", n_in, ws_size, (size_t)WS_END); grid = -1; return; }
    int dev = 0, cus = 0, per_cu = 0;
    hipGetDevice(&dev); hipDeviceGetAttribute(&cus, hipDeviceAttributeMultiprocessorCount, dev);
    if (hipFuncSetAttribute((const void*)mega, hipFuncAttributeMaxDynamicSharedMemorySize, LDS_BYTES) != hipSuccess) { fprintf(stderr, "kernel_launch: hipFuncSetAttribute failed\n"); grid = -1; return; }
    if (hipOccupancyMaxActiveBlocksPerMultiprocessor(&per_cu, (const void*)mega, 512, LDS_BYTES) != hipSuccess || per_cu < 1) { fprintf(stderr, "kernel_launch: occupancy query gave %d\n", per_cu); per_cu = 1; }
    (void)hipGetLastError();
    grid = cus * 1;
  }
  if (grid < 0) return;
  Params p{};
  p.x_prompt = (const float*)d_in[0]; p.x_sample = (const float*)d_in[1]; p.norm_g = (const float*)d_in[2];
  p.a_w_in = (const float*)d_in[3]; p.a_v_g = (const float*)d_in[4]; p.a_w_s = (const float*)d_in[5]; p.a_b_s = (const float*)d_in[6]; p.a_w_out = (const float*)d_in[7];
  p.b_w_in = (const float*)d_in[8]; p.b_w_gate = (const float*)d_in[9]; p.b_gate_bias = (const float*)d_in[10]; p.b_o_g = (const float*)d_in[11]; p.b_w_out = (const float*)d_in[12];
  p.c_w_in = (const float*)d_in[13]; p.c_q_g = (const float*)d_in[14]; p.c_k_g = (const float*)d_in[15]; p.c_lam = (const float*)d_in[16]; p.c_o_g = (const float*)d_in[17]; p.c_w_out = (const float*)d_in[18];
  p.out = (float*)d_out; p.ws = (unsigned char*)d_ws;
  (void)hipMemsetAsync((unsigned char*)d_ws + WS_BAR, 0, XCD_BAR_WORDS * sizeof(unsigned), stream);
  void* args[] = {&p};
  hipError_t e = hipLaunchCooperativeKernel((const void*)mega, dim3(grid), dim3(512), args, LDS_BYTES, stream);
  if (e != hipSuccess) fprintf(stderr, "cooperative launch failed: %s (grid %d)\n", hipGetErrorString(e), grid);
}
```
